# Optimizing an MI355X kernel written in HIP

```python
import math
import jax, jax.numpy as jnp
from jax import lax
import numpy as np

D_MODEL = 2048
BATCH = 2
SEQ = 4096
DEPTH = 1

HEAD_DIM = 128
N_HEAD_SLOTS = 8
DILATED_GROUPS = ((128, 1), (512, 4), (2048, 16))
N_GROUPS = len(DILATED_GROUPS)
ATTN_WIDTH = N_HEAD_SLOTS * HEAD_DIM
POOL_WINDOWS = (2, 4, 8, 16)
N_POOL_GROUPS = len(POOL_WINDOWS)
POOL_WIDTH = D_MODEL // 2
POOL_GROUP = POOL_WIDTH // N_POOL_GROUPS
N_BRANCHES = 2
SPLIT_SIZES = (N_GROUPS * ATTN_WIDTH,
               N_GROUPS * ATTN_WIDTH,
               N_GROUPS * ATTN_WIDTH,
               ATTN_WIDTH,
               POOL_WIDTH,
               POOL_WIDTH,
               N_BRANCHES * D_MODEL)
IN_WIDTH = sum(SPLIT_SIZES)
DEEPNORM_ALPHA = (2.0 * DEPTH) ** 0.25
DEEPNORM_BETA = (8.0 * DEPTH) ** -0.25
LN_EPS = 1e-5
NEG_INF = -1e30

kernel_name = "hybrid_dilated_attn_pool_gated_deepnorm"


def layer_norm(x, gamma, beta):
    xf = x.astype(jnp.float32)
    mu = jnp.mean(xf, axis=-1, keepdims=True)
    var = jnp.mean(jnp.square(xf - mu), axis=-1, keepdims=True)
    y = (xf - mu) * lax.rsqrt(var + LN_EPS) * gamma.astype(jnp.float32) + beta.astype(jnp.float32)
    return y.astype(x.dtype)


def dilated_window_attention(q, k, v, window, dilation):
    B, S, H, hd = q.shape
    steps = window // dilation
    span = steps * dilation
    Sp = -(-S // span) * span
    L = Sp // dilation
    nb = L // steps

    def to_blocks(t):
        t = jnp.pad(t, ((0, 0), (0, Sp - S), (0, 0), (0, 0)))
        t = t.reshape(B, L, dilation, H, hd).transpose(0, 2, 1, 3, 4)
        return t.reshape(B, dilation, nb, steps, H, hd)

    def with_prev(t):
        prev = jnp.pad(t[:, :, :-1], ((0, 0), (0, 0), (1, 0), (0, 0), (0, 0), (0, 0)))
        return jnp.concatenate([prev, t], axis=3)

    qb = to_blocks(q)
    kb = with_prev(to_blocks(k))
    vb = with_prev(to_blocks(v))
    scores = jnp.einsum('brnqhd,brnkhd->brnhqk', qb, kb,
                        preferred_element_type=jnp.float32) * (hd ** -0.5)
    qi = np.arange(steps)[:, None]
    kj = np.arange(2 * steps)[None, :]
    dist = steps + qi - kj
    blk = np.arange(nb)[:, None, None]
    mask = (dist >= 0) & (dist <= steps) & ((blk > 0) | (kj >= steps))[...]
    scores = jnp.where(jnp.asarray(mask)[None, None, :, None], scores, NEG_INF)
    m = jnp.max(scores, axis=-1, keepdims=True)
    e = jnp.exp(scores - m)
    den = jnp.sum(e, axis=-1)
    o = jnp.einsum('brnhqk,brnkhd->brnqhd', e.astype(v.dtype), vb,
                   preferred_element_type=jnp.float32)
    o = o / jnp.transpose(den, (0, 1, 2, 4, 3))[..., None]
    lse = m[..., 0] + jnp.log(den)
    o = o.reshape(B, dilation, L, H, hd).transpose(0, 2, 1, 3, 4).reshape(B, Sp, H, hd)[:, :S]
    lse = jnp.transpose(lse, (0, 1, 2, 4, 3)).reshape(B, dilation, L, H)
    lse = lse.transpose(0, 2, 1, 3).reshape(B, Sp, H)[:, :S]
    return o, lse


def causal_pool_mixer(u, w_pool, pool_scale):
    B, S, _ = u.shape
    uf = u.astype(jnp.float32)
    c = jnp.concatenate([jnp.zeros((B, 1, POOL_WIDTH), jnp.float32), jnp.cumsum(uf, axis=1)], axis=1)
    hi = np.arange(1, S + 1)
    outs = []
    for g, w in enumerate(POOL_WINDOWS):
        lo = np.maximum(hi - w, 0)
        cnt = np.minimum(hi, w).astype(np.float32)
        sl = slice(g * POOL_GROUP, (g + 1) * POOL_GROUP)
        window_sum = jnp.take(c[..., sl], hi, axis=1) - jnp.take(c[..., sl], lo, axis=1)
        outs.append(window_sum / jnp.asarray(cnt)[None, :, None] - uf[..., sl])
    p = jnp.stack(outs, axis=2).astype(u.dtype)
    y = jnp.einsum('bsgc,gcd->bsgd', p, w_pool).reshape(B, S, POOL_WIDTH)
    return y * pool_scale


def hybrid_layer(x, w_in, b_gate, w_pool, pool_scale, w_proj_attn, w_proj_pool, w_out, ln_gamma, ln_beta):
    B, S, _ = x.shape
    h = jnp.einsum('bsd,de->bse', x, w_in)
    idx = list(np.cumsum(SPLIT_SIZES)[:-1])
    q, k, v, z_attn, u_pool, z_pool, g_pre = jnp.split(h, idx, axis=-1)
    q = q.reshape(B, S, N_GROUPS, N_HEAD_SLOTS, HEAD_DIM)
    k = k.reshape(B, S, N_GROUPS, N_HEAD_SLOTS, HEAD_DIM)
    v = v.reshape(B, S, N_GROUPS, N_HEAD_SLOTS, HEAD_DIM)
    outs, lses = [], []
    for g, (window, dilation) in enumerate(DILATED_GROUPS):
        o_g, lse_g = dilated_window_attention(q[:, :, g], k[:, :, g], v[:, :, g], window, dilation)
        outs.append(o_g)
        lses.append(lse_g)
    wts = jax.nn.softmax(jnp.stack(lses, axis=0), axis=0)
    o = jnp.sum(wts[..., None] * jnp.stack(outs, axis=0), axis=0).reshape(B, S, ATTN_WIDTH)
    y_attn = o.astype(x.dtype) * jax.nn.silu(z_attn)
    y_pool = causal_pool_mixer(u_pool, w_pool, pool_scale) * jax.nn.silu(z_pool)
    gates = jax.nn.sigmoid((g_pre + b_gate).astype(jnp.float32)).astype(x.dtype)
    g_attn, g_pool = jnp.split(gates, 2, axis=-1)
    merged = g_attn * jnp.einsum('bsc,cd->bsd', y_attn, w_proj_attn) \
        + g_pool * jnp.einsum('bsc,cd->bsd', y_pool, w_proj_pool)
    out = jnp.einsum('bsd,de->bse', merged, w_out)
    return layer_norm(DEEPNORM_ALPHA * x + out, ln_gamma, ln_beta)


def setup_inputs(seed: int = 0) -> dict:
    key = jax.random.key(seed)
    ks = jax.random.split(key, 11)
    f32 = jnp.float32
    x = jax.random.normal(ks[0], (BATCH, SEQ, D_MODEL), f32)
    w_in = jax.random.normal(ks[1], (DEPTH, D_MODEL, IN_WIDTH), f32) * D_MODEL ** -0.5
    b_gate = jax.random.normal(ks[2], (DEPTH, N_BRANCHES * D_MODEL), f32) * 0.02
    w_pool = jax.random.normal(ks[3], (DEPTH, N_POOL_GROUPS, POOL_GROUP, POOL_GROUP), f32) * POOL_GROUP ** -0.5
    pool_scale = 1.0 + 0.02 * jax.random.normal(ks[4], (DEPTH, POOL_WIDTH), f32)
    w_proj_attn = jax.random.normal(ks[5], (DEPTH, ATTN_WIDTH, D_MODEL), f32) * ATTN_WIDTH ** -0.5 * DEEPNORM_BETA
    w_proj_pool = jax.random.normal(ks[6], (DEPTH, POOL_WIDTH, D_MODEL), f32) * POOL_WIDTH ** -0.5 * DEEPNORM_BETA
    w_out = jax.random.normal(ks[7], (DEPTH, D_MODEL, D_MODEL), f32) * D_MODEL ** -0.5 * DEEPNORM_BETA
    ln_gamma = 1.0 + 0.02 * jax.random.normal(ks[8], (DEPTH, D_MODEL), f32)
    ln_beta = 0.02 * jax.random.normal(ks[9], (DEPTH, D_MODEL), f32)
    return {"x": x, "w_in": w_in, "b_gate": b_gate, "w_pool": w_pool, "pool_scale": pool_scale,
            "w_proj_attn": w_proj_attn, "w_proj_pool": w_proj_pool, "w_out": w_out,
            "ln_gamma": ln_gamma, "ln_beta": ln_beta}


def reference(x, w_in, b_gate, w_pool, pool_scale, w_proj_attn, w_proj_pool, w_out, ln_gamma, ln_beta):
    for layer in range(DEPTH):
        x = hybrid_layer(x, w_in[layer], b_gate[layer], w_pool[layer], pool_scale[layer],
                         w_proj_attn[layer], w_proj_pool[layer], w_out[layer],
                         ln_gamma[layer], ln_beta[layer])
    return x
```

```cpp
#include <hip/hip_runtime.h>
#include <hip/hip_cooperative_groups.h>
#include <cstdio>
#include <cstdint>
namespace cg = cooperative_groups;

namespace pg8 {
#define PG8_LAS __attribute__((address_space(3)))
typedef unsigned short bf16_t;
typedef short bf16x8 __attribute__((ext_vector_type(8)));
typedef float f32x4 __attribute__((ext_vector_type(4)));
typedef unsigned u32x4 __attribute__((ext_vector_type(4)));
constexpr int BM = 256, BK = 64, HALF = 128, HTB = HALF * BK * 2  , STAGE_BYTES = 8 * HTB, NXCD = 8, WGM = 8;

__host__ __device__ __forceinline__ int lds_byte(int r, int c) { const int st = (r >> 4) * 2 + (c >> 5), rr = r & 15, cc = c & 31, ob = rr * 64 + cc * 2; return st * 1024 + (ob ^ (((ob >> 9) & 1) << 5)); }
__host__ __device__ __forceinline__ void stage_rc(int b, int& R, int& C) { const int st = b / 1024, sb = b % 1024, swz = sb ^ (((sb >> 9) & 1) << 5); R = (st >> 1) * 16 + swz / 64; C = (st & 1) * 32 + (swz % 64) / 2; }
__host__ __device__ __forceinline__ int perm32(int rho) { const int n = rho >> 4, i = rho & 15; return 8 * (i >> 2) + 4 * n + (i & 3); }

struct Unit { int pm, pn, pk; };
struct Gemm { const bf16_t* A; const bf16_t* Bt; int M, N, K, lda, ldb, a_pn_off, kpart; };

struct StaticOrder {
    int nM, nN, nwg, G, c;
    __host__ __device__ void init(int M, int N, int G_, int c_) { nM = M / BM; nN = N / BM; nwg = nM * nN; G = G_; c = c_; }
    __host__ __device__ bool next(int i, Unit& u) const {
        const long L = (long)i * G + c; if (L >= nwg) return false;
        int wgid = (int)L; { const int q = nwg / NXCD, r = nwg % NXCD, xcd = wgid % NXCD, off = wgid / NXCD; wgid = (xcd < r ? xcd * (q + 1) : r * (q + 1) + (xcd - r) * q) + off; }
        const int nig = WGM * nN, gid = wgid / nig, fm = gid * WGM, gsz = (nM - fm) < WGM ? (nM - fm) : WGM;
        u.pm = fm + ((wgid % nig) % gsz); u.pn = (wgid % nig) / gsz; u.pk = 0; return true;
    }
    __device__ __forceinline__ void a_ready(const Unit&) const {}
    __device__ __forceinline__ void done(const Unit&) const {}
};
struct HalfOrder {
    StaticOrder base;
    __host__ __device__ void init(int M, int N, int G_, int c_) { base.init(M, N, G_, c_); }
    __host__ __device__ bool next(int i, Unit& u) const { if (!base.next(i >> 1, u)) return false; u.pk = i & 1; return true; }
    __device__ __forceinline__ void a_ready(const Unit&) const {}
    __device__ __forceinline__ void done(const Unit&) const {}
};

template <class Epi, class Sched, bool ALIGN_EPI = false, bool SP2 = false>
__device__ __forceinline__ void gemm_phase(PG8_LAS unsigned char* lds, const Gemm g, const Sched& S, const Epi& E) {
    const int tid = threadIdx.x, wid = __builtin_amdgcn_readfirstlane(tid >> 6), lane = tid & 63, wr = wid >> 2, wc = wid & 3, fr = lane & 15, fq = lane >> 4;
    const int K = g.K, nt = K / BK;
    unsigned voffA[2], voffB[2];
#pragma unroll
    for (int i = 0; i < 2; ++i) { int R, C; stage_rc(tid * 16 + i * 8192, R, C); const int Rb = Epi::PERM ? ((R & ~31) + perm32(R & 31)) : R;
        voffA[i] = (unsigned)(R * g.lda + C) * 2u; voffB[i] = (unsigned)(Rb * g.ldb + C) * 2u; }
    const size_t kstep = (size_t)(BK * 2);
    const size_t hstepA = (size_t)HALF * g.lda * 2, hstepB = (size_t)HALF * g.ldb * 2;
    const size_t tstepA = 2 * hstepA, tstepB = 2 * hstepB;
    const unsigned ldsw = (unsigned)wid * 1024u;
    const int aoff = lds_byte(wr * 64 + fr, fq * 8), boff = lds_byte(wc * 32 + fr, fq * 8);
#define PG8_SA(b, h) (((b) * 2 + (h)) * HTB)
#define PG8_SB(b, h) ((4 + (b) * 2 + (h)) * HTB)
#define PG8_STAGE(bufoff, gbase, voff) do { _Pragma("unroll") for (int _i = 0; _i < 2; ++_i) \
        __builtin_amdgcn_global_load_lds((const unsigned*)((const char*)(gbase) + (voff)[_i]), (PG8_LAS unsigned*)(lds + (bufoff) + ldsw + _i * 8192), 16, 0, 0); } while (0)
#define PG8_LDA(dst, b, h) do { _Pragma("unroll") for (int m = 0; m < 4; ++m) _Pragma("unroll") for (int k = 0; k < 2; ++k) dst[m][k] = *(const PG8_LAS bf16x8*)(lds + PG8_SA(b, h) + aoff + m * 2048 + k * 1024); } while (0)
#define PG8_LDB(dst, b, h) do { _Pragma("unroll") for (int n = 0; n < 2; ++n) _Pragma("unroll") for (int k = 0; k < 2; ++k) dst[n][k] = *(const PG8_LAS bf16x8*)(lds + PG8_SB(b, h) + boff + n * 2048 + k * 1024); } while (0)
#define PG8_MMA(ai, bj, At, Bt) do { __builtin_amdgcn_s_setprio(1); _Pragma("unroll") for (int m = 0; m < 4; ++m) _Pragma("unroll") for (int n = 0; n < 2; ++n) _Pragma("unroll") for (int k = 0; k < 2; ++k) \
        acc[ai][bj][m][n] = __builtin_amdgcn_mfma_f32_16x16x32_bf16(Bt[n][k], At[m][k], acc[ai][bj][m][n], 0, 0, 0); __builtin_amdgcn_s_setprio(0); } while (0)
#define PG8_WAIT_V(n) asm volatile("s_waitcnt vmcnt(" #n ")" ::: "memory")
#define PG8_WAIT_L(n) asm volatile("s_waitcnt lgkmcnt(" #n ")" ::: "memory")
#define PG8_BAR __builtin_amdgcn_s_barrier()
#define PG8_SCHED __builtin_amdgcn_sched_barrier(0)
    Unit cur, nxt; int ui = 0;
    if (!S.next(0, cur)) return;
    f32x4 acc[2][2][4][2];
#pragma unroll
    for (int a = 0; a < 2; ++a)
#pragma unroll
        for (int b = 0; b < 2; ++b)
#pragma unroll
            for (int m = 0; m < 4; ++m)
#pragma unroll
                for (int n = 0; n < 2; ++n) acc[a][b][m][n] = (f32x4){0.f, 0.f, 0.f, 0.f};
    bf16x8 At[4][2], B0[2][2], B1[2][2];
    const char* cA = (const char*)g.A + (size_t)cur.pm * tstepA + (size_t)cur.pn * g.a_pn_off + (size_t)cur.pk * g.kpart; const char* cB = (const char*)g.Bt + (size_t)cur.pn * tstepB + (size_t)cur.pk * g.kpart;
    S.a_ready(cur);
    if constexpr (SP2) {
        PG8_STAGE(PG8_SB(0, 0), cB, voffB); PG8_STAGE(PG8_SB(0, 1), cB + hstepB, voffB); PG8_STAGE(PG8_SA(0, 0), cA, voffA); PG8_STAGE(PG8_SA(0, 1), cA + hstepA, voffA);
        if (wr == 1) PG8_BAR;
        PG8_WAIT_V(2); PG8_BAR;
        PG8_STAGE(PG8_SB(1, 0), cB + kstep, voffB); PG8_STAGE(PG8_SA(1, 0), cA + kstep, voffA); PG8_STAGE(PG8_SB(1, 1), cB + hstepB + kstep, voffB);
        PG8_WAIT_V(6); PG8_BAR;
    } else {
        PG8_STAGE(PG8_SB(0, 0), cB, voffB); PG8_STAGE(PG8_SA(0, 0), cA, voffA); PG8_STAGE(PG8_SB(0, 1), cB + hstepB, voffB); PG8_STAGE(PG8_SA(0, 1), cA + hstepA, voffA);
        if (wr == 1) PG8_BAR;
        PG8_WAIT_V(4); PG8_BAR;
        PG8_STAGE(PG8_SB(1, 0), cB + kstep, voffB); PG8_STAGE(PG8_SA(1, 0), cA + kstep, voffA); PG8_STAGE(PG8_SB(1, 1), cB + hstepB + kstep, voffB);
        PG8_WAIT_V(6); PG8_BAR;
    }
    for (;;) {
        const bool has_next = S.next(ui + 1, nxt);
        const char* nA = has_next ? (const char*)g.A + (size_t)nxt.pm * tstepA + (size_t)nxt.pn * g.a_pn_off + (size_t)nxt.pk * g.kpart : cA; const char* nB = has_next ? (const char*)g.Bt + (size_t)nxt.pn * tstepB + (size_t)nxt.pk * g.kpart : cB;
#pragma nounroll
        for (int t = 0; t < nt; t += 2) {
            const bool last = (t == nt - 2);
            const char* a1 = cA + (size_t)(t + 1) * kstep;
            const char* a2 = last ? nA : cA + (size_t)(t + 2) * kstep; const char* b2 = last ? nB : cB + (size_t)(t + 2) * kstep;
            const char* a3 = a2 + kstep; const char* b3 = b2 + kstep;
            if (last && has_next) S.a_ready(nxt);
            if constexpr (SP2) {
            PG8_LDB(B0, 0, 0); PG8_LDB(B1, 0, 1); PG8_SCHED; PG8_LDA(At, 0, 0); PG8_STAGE(PG8_SA(1, 1), a1 + hstepA, voffA);
            PG8_WAIT_V(8); PG8_WAIT_L(0); PG8_BAR; PG8_MMA(0, 0, At, B0); PG8_MMA(0, 1, At, B1); PG8_BAR; PG8_SCHED;
            PG8_LDA(At, 0, 1); PG8_STAGE(PG8_SB(0, 0), b2, voffB); PG8_STAGE(PG8_SB(0, 1), b2 + hstepB, voffB); PG8_STAGE(PG8_SA(0, 0), a2, voffA);
            PG8_WAIT_V(8); PG8_WAIT_L(0); PG8_BAR; PG8_MMA(1, 0, At, B0); PG8_MMA(1, 1, At, B1); PG8_BAR; PG8_SCHED;
            PG8_LDB(B0, 1, 0); PG8_LDB(B1, 1, 1); PG8_SCHED; PG8_LDA(At, 1, 0); PG8_STAGE(PG8_SA(0, 1), a2 + hstepA, voffA);
            PG8_WAIT_V(8); PG8_WAIT_L(0); PG8_BAR; PG8_MMA(0, 0, At, B0); PG8_MMA(0, 1, At, B1); PG8_BAR; PG8_SCHED;
            PG8_LDA(At, 1, 1); PG8_STAGE(PG8_SB(1, 0), b3, voffB); PG8_STAGE(PG8_SB(1, 1), b3 + hstepB, voffB); PG8_STAGE(PG8_SA(1, 0), a3, voffA);
            PG8_WAIT_V(8); PG8_WAIT_L(0); PG8_BAR; PG8_MMA(1, 0, At, B0); PG8_MMA(1, 1, At, B1); PG8_BAR; PG8_SCHED;
            } else {
            PG8_LDB(B0, 0, 0); PG8_SCHED; PG8_LDA(At, 0, 0); PG8_STAGE(PG8_SA(1, 1), a1 + hstepA, voffA);
            PG8_WAIT_L(8); PG8_BAR; PG8_WAIT_L(0); PG8_MMA(0, 0, At, B0); PG8_BAR; PG8_SCHED;
            PG8_LDB(B1, 0, 1); PG8_STAGE(PG8_SB(0, 0), b2, voffB);
            PG8_BAR; PG8_WAIT_L(0); PG8_MMA(0, 1, At, B1); PG8_BAR;
            PG8_LDA(At, 0, 1); PG8_STAGE(PG8_SA(0, 0), a2, voffA);
            PG8_BAR; PG8_WAIT_L(0); PG8_MMA(1, 0, At, B0); PG8_BAR; PG8_SCHED;
            PG8_STAGE(PG8_SB(0, 1), b2 + hstepB, voffB);
            PG8_WAIT_V(6); PG8_BAR; PG8_MMA(1, 1, At, B1); PG8_BAR;
            PG8_LDB(B0, 1, 0); PG8_SCHED; PG8_LDA(At, 1, 0); PG8_STAGE(PG8_SA(0, 1), a2 + hstepA, voffA);
            PG8_WAIT_L(8); PG8_BAR; PG8_WAIT_L(0); PG8_MMA(0, 0, At, B0); PG8_BAR; PG8_SCHED;
            PG8_LDB(B1, 1, 1); PG8_STAGE(PG8_SB(1, 0), b3, voffB);
            PG8_BAR; PG8_WAIT_L(0); PG8_MMA(0, 1, At, B1); PG8_BAR;
            PG8_LDA(At, 1, 1); PG8_STAGE(PG8_SA(1, 0), a3, voffA);
            PG8_BAR; PG8_WAIT_L(0); PG8_MMA(1, 0, At, B0); PG8_BAR; PG8_SCHED;
            PG8_STAGE(PG8_SB(1, 1), b3 + hstepB, voffB);
            PG8_WAIT_V(6); PG8_BAR; PG8_MMA(1, 1, At, B1); PG8_BAR;
            }
        }
        if constexpr (ALIGN_EPI) { if (wr == 0) PG8_BAR; }
        if constexpr (!Epi::AFTER_DRAIN) { E(acc, cur, wr, wc, fr, fq); S.done(cur); }
        if (!has_next) break;
        if (!(Epi::MIDK && cur.pk == 0))
#pragma unroll
        for (int a = 0; a < 2; ++a)
#pragma unroll
            for (int b = 0; b < 2; ++b)
#pragma unroll
                for (int m = 0; m < 4; ++m)
#pragma unroll
                    for (int n = 0; n < 2; ++n) acc[a][b][m][n] = (f32x4){0.f, 0.f, 0.f, 0.f};
        cur = nxt; cA = nA; cB = nB; ++ui;
        if constexpr (ALIGN_EPI) { if (wr == 1) PG8_BAR; }
    }
    PG8_WAIT_V(0);
    if constexpr (!ALIGN_EPI) { if (wr == 0) PG8_BAR; }
    PG8_BAR;
    if constexpr (Epi::AFTER_DRAIN) { E.fused(acc, cur, wr, wc, fr, fq, lds, wid, lane); S.done(cur); }
#undef PG8_SA
#undef PG8_SB
#undef PG8_STAGE
#undef PG8_LDA
#undef PG8_LDB
#undef PG8_MMA
#undef PG8_WAIT_V
#undef PG8_WAIT_L
#undef PG8_BAR
#undef PG8_SCHED
}
}

namespace pg8 {
typedef float f32x2_t __attribute__((ext_vector_type(2))); typedef __bf16 bf16x2_t __attribute__((ext_vector_type(2)));
__device__ __forceinline__ unsigned cvtpk(float lo, float hi) { f32x2_t v = {lo, hi}; bf16x2_t b = __builtin_convertvector(v, bf16x2_t); return __builtin_bit_cast(unsigned, b); }
__device__ __forceinline__ float bf_lo(unsigned w) { return __uint_as_float(w << 16); }
__device__ __forceinline__ float bf_hi(unsigned w) { return __uint_as_float(w & 0xffff0000u); }
__device__ __forceinline__ float sigmoidf_(float v) { return __builtin_amdgcn_rcpf(1.0f + __builtin_amdgcn_exp2f(-1.4426950408889634f * v)); }
__device__ __forceinline__ u32x4 pack8(const f32x4& a, const f32x4& b) { u32x4 w; w.x = cvtpk(a[0], a[1]); w.y = cvtpk(a[2], a[3]); w.z = cvtpk(b[0], b[1]); w.w = cvtpk(b[2], b[3]); return w; }
__device__ __forceinline__ void unpack8(const u32x4& w, f32x4& a, f32x4& b) { a = (f32x4){bf_lo(w.x), bf_hi(w.x), bf_lo(w.y), bf_hi(w.y)}; b = (f32x4){bf_lo(w.z), bf_hi(w.z), bf_lo(w.w), bf_hi(w.w)}; }

constexpr int HW = 16384;
constexpr float QSCALE = 0.08838834764831845f * 1.4426950408889634f;
struct EpiH {
    static constexpr bool PERM = true, AFTER_DRAIN = false, MIDK = false;
    bf16_t* H; const float* b_gate;
    __device__ __forceinline__ void operator()(const f32x4 (&acc)[2][2][4][2], const Unit& u, int wr, int wc, int fr, int fq) const {
        const int colt = u.pn * BM, row0 = u.pm * BM + wr * 64 + fr, col0 = colt + wc * 32 + 8 * fq;
        const int mode = colt < 3072 ? 1 : (colt < 9216 ? 0 : (colt < 10240 ? 2 : (colt < 11264 ? 0 : (colt < 12288 ? 2 : 3))));
        f32x4 bv[2][2];
#pragma unroll
        for (int bj = 0; bj < 2; ++bj)
#pragma unroll
            for (int n = 0; n < 2; ++n) bv[bj][n] = (mode == 3) ? *(const f32x4*)(b_gate + (col0 - 12288) + bj * HALF + 4 * n) : (f32x4){0.f, 0.f, 0.f, 0.f};
#pragma unroll
        for (int ai = 0; ai < 2; ++ai)
#pragma unroll
            for (int m = 0; m < 4; ++m) { bf16_t* rowp = H + (size_t)(row0 + ai * HALF + m * 16) * HW + col0;
#pragma unroll
                for (int bj = 0; bj < 2; ++bj) { f32x4 v0 = acc[ai][bj][m][0], v1 = acc[ai][bj][m][1];
                    if (mode == 1) { v0 = v0 * QSCALE; v1 = v1 * QSCALE; }
                    else if (mode == 2) {
#pragma unroll
                        for (int e = 0; e < 4; ++e) { v0[e] = v0[e] * sigmoidf_(v0[e]); v1[e] = v1[e] * sigmoidf_(v1[e]); } }
                    else if (mode == 3) { v0 = v0 + bv[bj][0]; v1 = v1 + bv[bj][1];
#pragma unroll
                        for (int e = 0; e < 4; ++e) { v0[e] = sigmoidf_(v0[e]); v1[e] = sigmoidf_(v1[e]); } }
                    *(u32x4*)(rowp + bj * HALF) = pack8(v0, v1); } }
    }
};
struct EpiPool {
    static constexpr bool PERM = true, AFTER_DRAIN = false, MIDK = false;
    const bf16_t* H; const float* pool_scale; bf16_t* Y;
    __device__ __forceinline__ void operator()(const f32x4 (&acc)[2][2][4][2], const Unit& u, int wr, int wc, int fr, int fq) const {
        const int row0 = u.pm * BM + wr * 64 + fr, col0 = u.pn * BM + wc * 32 + 8 * fq;
#pragma unroll
        for (int bj = 0; bj < 2; ++bj) { const int col = col0 + bj * HALF;
            const f32x4 s0 = *(const f32x4*)(pool_scale + col), s1 = *(const f32x4*)(pool_scale + col + 4);
#pragma unroll
            for (int ai = 0; ai < 2; ++ai)
#pragma unroll
                for (int m = 0; m < 4; ++m) { const size_t row = (size_t)(row0 + ai * HALF + m * 16);
                    f32x4 z0, z1; unpack8(*(const u32x4*)(H + row * HW + 11264 + col), z0, z1);
                    *(u32x4*)(Y + row * 2048 + 1024 + col) = pack8(acc[ai][bj][m][0] * s0 * z0, acc[ai][bj][m][1] * s1 * z1);
                    if (m & 1) asm volatile("" ::: "memory"); } }
    }
};
struct EpiMerge {
    static constexpr bool PERM = true, AFTER_DRAIN = false, MIDK = true;
    const bf16_t* H; bf16_t* Mg;
    __device__ __forceinline__ void operator()(f32x4 (&acc)[2][2][4][2], const Unit& u, int wr, int wc, int fr, int fq) const {
        const int row0 = u.pm * BM + wr * 64 + fr, col0 = u.pn * BM + wc * 32 + 8 * fq;
        if (u.pk == 0) {
#pragma unroll
        for (int ai = 0; ai < 2; ++ai)
#pragma unroll
            for (int m = 0; m < 4; ++m) { const bf16_t* hp = H + (size_t)(row0 + ai * HALF + m * 16) * HW + 12288 + col0;
#pragma unroll
                for (int bj = 0; bj < 2; ++bj) { f32x4 a0, a1, p0, p1; unpack8(*(const u32x4*)(hp + bj * HALF), a0, a1); unpack8(*(const u32x4*)(hp + 2048 + bj * HALF), p0, p1);
#pragma unroll
                    for (int e = 0; e < 4; ++e) { acc[ai][bj][m][0][e] *= a0[e] * __builtin_amdgcn_rcpf(p0[e]); acc[ai][bj][m][1][e] *= a1[e] * __builtin_amdgcn_rcpf(p1[e]); } } }
        } else {
#pragma unroll
        for (int ai = 0; ai < 2; ++ai)
#pragma unroll
            for (int m = 0; m < 4; ++m) { const size_t row = (size_t)(row0 + ai * HALF + m * 16);
#pragma unroll
                for (int bj = 0; bj < 2; ++bj) { const int col = col0 + bj * HALF; f32x4 p0, p1; unpack8(*(const u32x4*)(H + row * HW + 14336 + col), p0, p1);
                    *(u32x4*)(Mg + row * 2048 + col) = pack8(acc[ai][bj][m][0] * p0, acc[ai][bj][m][1] * p1); } }
        }
    }
};
struct EpiOut {
    static constexpr bool PERM = true, AFTER_DRAIN = false, MIDK = false;
    const float* x; float* out; float alpha;
    __device__ __forceinline__ void operator()(const f32x4 (&acc)[2][2][4][2], const Unit& u, int wr, int wc, int fr, int fq) const {
        const int row0 = u.pm * BM + wr * 64 + fr, col0 = u.pn * BM + wc * 32 + 8 * fq;
#pragma unroll
        for (int ai = 0; ai < 2; ++ai)
#pragma unroll
            for (int m = 0; m < 4; ++m) { const size_t off = (size_t)(row0 + ai * HALF + m * 16) * 2048 + col0;
#pragma unroll
                for (int bj = 0; bj < 2; ++bj)
#pragma unroll
                    for (int n = 0; n < 2; ++n) { const f32x4 xv = *(const f32x4*)(x + off + bj * HALF + 4 * n); *(f32x4*)(out + off + bj * HALF + 4 * n) = xv * alpha + acc[ai][bj][m][n]; } }
    }
};
}

#define LAS __attribute__((address_space(3)))
typedef unsigned short bf16_t;
typedef short bf16x8 __attribute__((ext_vector_type(8)));
typedef short s16x4 __attribute__((ext_vector_type(4)));
typedef float f32x4 __attribute__((ext_vector_type(4)));
typedef unsigned u32x4 __attribute__((ext_vector_type(4)));
typedef unsigned u32x2 __attribute__((ext_vector_type(2)));
using pg8::cvtpk; using pg8::pack8; using pg8::unpack8;

constexpr int SEQ = 4096, NTOK = 8192, DM = 2048, HW = 16384, NTHREADS = 512;
constexpr size_t MiB = 1u << 20;
constexpr size_t WS_WINT = 0, WS_XB = 64 * MiB, WS_WPT = 96 * MiB, WS_WOT = 104 * MiB, WS_WPLT = 112 * MiB, WS_LSE = 113 * MiB, WS_H = 128 * MiB, WS_END = 384 * MiB;
constexpr size_t WS_OG = 0, WS_PP = 48 * MiB, WS_Y = 64 * MiB, WS_MG = 0;
constexpr int LDS_BYTES = 147456;
constexpr int LDS_KOFF = 0, LDS_VOFF = 65536;
constexpr float LN_EPS = 1e-5f;
#ifndef PHMASK
#define PHMASK 0x7f
#endif
constexpr float ALPHA = 1.189207115002721f;

__device__ __forceinline__ void p0_transpose_item(const float* __restrict__ W, int N, bf16_t* __restrict__ WT, int ldo, int koff, LAS float* scr, int item, int lane) {
    const int nblk = N / 32, kb = item / nblk, nb = item % nblk, k0 = 64 * kb, n0 = 32 * nb;
#pragma unroll 8
    for (int i = 0; i < 32; ++i) { const int kk = 2 * i + (lane >> 5); scr[kk * 33 + (lane & 31)] = W[(size_t)(k0 + kk) * N + n0 + (lane & 31)]; }
    asm volatile("s_waitcnt lgkmcnt(0)" ::: "memory");
    const int c = lane & 7;
#pragma unroll
    for (int j = 0; j < 4; ++j) { const int n = (lane >> 3) + 8 * j; const LAS float* s = scr + (8 * c) * 33 + n;
        u32x4 o; o.x = cvtpk(s[0 * 33], s[1 * 33]); o.y = cvtpk(s[2 * 33], s[3 * 33]); o.z = cvtpk(s[4 * 33], s[5 * 33]); o.w = cvtpk(s[6 * 33], s[7 * 33]);
        *(u32x4*)(WT + (size_t)(n0 + n) * ldo + koff + k0 + 8 * c) = o; }
    asm volatile("s_waitcnt lgkmcnt(0)" ::: "memory");
}

__device__ __forceinline__ unsigned offk(int row, int ch) { return (unsigned)(row * 256 + 16 * (ch ^ (row & 15))); }
__device__ __forceinline__ unsigned offv(int row, int ch) { return (unsigned)(row * 256 + 16 * (ch ^ (((row & 3) << 2) | ((row >> 2) & 3)))); }
typedef short v4i16_t __attribute__((ext_vector_type(4)));
__device__ __forceinline__ s16x4 vtr(LAS unsigned char* p) { return __builtin_bit_cast(s16x4, __builtin_amdgcn_ds_read_tr16_b64_v4i16((LAS v4i16_t*)p)); }
#define MFMA16(a, b, c) __builtin_amdgcn_mfma_f32_16x16x32_bf16((a), (b), (c), 0, 0, 0)

__device__ __forceinline__ void attn_unit(LAS unsigned char* lds, const bf16_t* __restrict__ H, bf16_t* __restrict__ Og, float* __restrict__ Lse, int unit) {
    const int tid = threadIdx.x, lane = tid & 63, wid = __builtin_amdgcn_readfirstlane(tid >> 6);
    const int blk = unit & 31, h = (unit >> 5) & 7, bg = unit >> 8, g = bg % 3, b = bg / 3;
    const int dsh = 2 * g, dil = 1 << dsh, r = blk & (dil - 1), n = blk >> dsh;
    const size_t tok0 = (size_t)b * SEQ + r;
    const int qcol = g * 1024 + h * 128;
    const int ql = lane & 15, g4 = lane >> 4;
    const int qi = 16 * wid + ql;
    const size_t qtok = tok0 + ((size_t)(n * 128 + qi) << dsh);
    bf16x8 qf[4];
    { const bf16_t* qp = H + qtok * HW + qcol + 8 * g4;
#pragma unroll
      for (int s = 0; s < 4; ++s) qf[s] = *(const bf16x8*)(qp + 32 * s); }
    {
        const int ch = tid & 15, r0 = tid >> 4;
        u32x4 kv[8], vv[8];
#pragma unroll
        for (int i = 0; i < 8; ++i) { const int row = r0 + 32 * i, j = (n - 1) * 128 + row;
            if (j >= 0) { const bf16_t* p = H + (tok0 + ((size_t)j << dsh)) * HW + 3072 + qcol + ch * 8; kv[i] = *(const u32x4*)p; vv[i] = *(const u32x4*)(p + 3072); }
            else { kv[i] = (u32x4){0u, 0u, 0u, 0u}; vv[i] = (u32x4){0u, 0u, 0u, 0u}; } }
#pragma unroll
        for (int i = 0; i < 8; ++i) { const int row = r0 + 32 * i;
            *(LAS u32x4*)(lds + LDS_KOFF + offk(row, ch)) = kv[i]; *(LAS u32x4*)(lds + LDS_VOFF + offv(row, ch)) = vv[i]; }
    }
    __syncthreads();
    f32x4 sc[9];
#pragma unroll
    for (int kt = 0; kt < 9; ++kt) { f32x4 a = (f32x4){0.f, 0.f, 0.f, 0.f}; const int krow = 16 * (wid + kt) + ql;
#pragma unroll
        for (int s = 0; s < 4; ++s) { const bf16x8 kf = *(const LAS bf16x8*)(lds + LDS_KOFF + offk(krow, 4 * s + g4)); a = MFMA16(kf, qf[s], a); }
        sc[kt] = a; }
    float mx = -INFINITY;
#pragma unroll
    for (int kt = 0; kt < 9; ++kt)
#pragma unroll
        for (int i = 0; i < 4; ++i) { const int dist = 16 * kt + 4 * g4 + i - ql, kj = 16 * (wid + kt) + 4 * g4 + i;
            const bool ok = (dist >= 0) && (dist <= 128) && (n > 0 || kj >= 128);
            const float v = ok ? sc[kt][i] : -INFINITY; sc[kt][i] = v; mx = fmaxf(mx, v); }
    mx = fmaxf(mx, __shfl_xor(mx, 16)); mx = fmaxf(mx, __shfl_xor(mx, 32));
    float l = 0.f;
#pragma unroll
    for (int kt = 0; kt < 9; ++kt)
#pragma unroll
        for (int i = 0; i < 4; ++i) { const float e = __builtin_amdgcn_exp2f(sc[kt][i] - mx); sc[kt][i] = e; l += e; }
    l += __shfl_xor(l, 16); l += __shfl_xor(l, 32);
    bf16x8 pf[5];
#pragma unroll
    for (int ks = 0; ks < 5; ++ks) { u32x4 w; w.x = cvtpk(sc[2 * ks][0], sc[2 * ks][1]); w.y = cvtpk(sc[2 * ks][2], sc[2 * ks][3]);
        if (2 * ks + 1 < 9) { w.z = cvtpk(sc[(2 * ks + 1) % 9][0], sc[(2 * ks + 1) % 9][1]); w.w = cvtpk(sc[(2 * ks + 1) % 9][2], sc[(2 * ks + 1) % 9][3]); } else { w.z = 0u; w.w = 0u; }
        pf[ks] = __builtin_bit_cast(bf16x8, w); }
    f32x4 o[8];
#pragma unroll
    for (int dt = 0; dt < 8; ++dt) o[dt] = (f32x4){0.f, 0.f, 0.f, 0.f};
    const int q4 = ql >> 2, p = ql & 3;
#pragma unroll
    for (int ks = 0; ks < 5; ++ks) { const int row0 = (16 * (wid + 2 * ks) + 4 * g4 + q4) & 255, row1 = (row0 + 16) & 255;
#pragma unroll
        for (int dt = 0; dt < 8; ++dt) { const int ch = 2 * dt + (p >> 1);
            const s16x4 lo = vtr(lds + LDS_VOFF + offv(row0, ch) + 8 * (p & 1)), hi = vtr(lds + LDS_VOFF + offv(row1, ch) + 8 * (p & 1));
            const bf16x8 vf = __builtin_shufflevector(lo, hi, 0, 1, 2, 3, 4, 5, 6, 7);
            o[dt] = MFMA16(vf, pf[ks], o[dt]); } }
    const float inv = 1.0f / l;
    bf16_t* op = Og + ((size_t)g * NTOK + qtok) * 1024 + h * 128 + 4 * g4;
#pragma unroll
    for (int dt = 0; dt < 8; ++dt) { u32x2 w; w.x = cvtpk(o[dt][0] * inv, o[dt][1] * inv); w.y = cvtpk(o[dt][2] * inv, o[dt][3] * inv); *(u32x2*)(op + 16 * dt) = w; }
    if (g4 == 0) Lse[((size_t)g * NTOK + qtok) * 8 + h] = mx + __builtin_amdgcn_logf(l);
    __syncthreads();
}

__device__ __forceinline__ void poolprep(const bf16_t* __restrict__ H, bf16_t* __restrict__ Pp, int gt, int NT) {
    for (int it = gt; it < NTOK * 128; it += NT) {
        const int tok = it >> 7, cc = it & 127, w = 2 << (cc >> 5), t = tok & (SEQ - 1), cnt = (t + 1 < w) ? t + 1 : w;
        const bf16_t* up = H + (size_t)tok * HW + 10240 + cc * 8;
        f32x4 s0 = (f32x4){0.f, 0.f, 0.f, 0.f}, s1 = s0, u0, u1;
        unpack8(*(const u32x4*)up, u0, u1); s0 = u0; s1 = u1;
        for (int k = 1; k < cnt; ++k) { f32x4 a, c; unpack8(*(const u32x4*)(up - (size_t)k * HW), a, c); s0 += a; s1 += c; }
        const float rc = 1.0f / (float)cnt;
        *(u32x4*)(Pp + (size_t)tok * 1024 + cc * 8) = pack8(s0 * rc - u0, s1 * rc - u1);
    }
}
__device__ __forceinline__ void combine(const bf16_t* __restrict__ H, const bf16_t* __restrict__ Og, const float* __restrict__ Lse, bf16_t* __restrict__ Y, int gt, int NT) {
    for (int it = gt; it < NTOK * 128; it += NT) {
        const int tok = it >> 7, cc = it & 127, hh = cc >> 4;
        const float l0 = Lse[((size_t)0 * NTOK + tok) * 8 + hh], l1 = Lse[((size_t)1 * NTOK + tok) * 8 + hh], l2 = Lse[((size_t)2 * NTOK + tok) * 8 + hh];
        const float mx = fmaxf(l0, fmaxf(l1, l2));
        float w0 = __builtin_amdgcn_exp2f(l0 - mx), w1 = __builtin_amdgcn_exp2f(l1 - mx), w2 = __builtin_amdgcn_exp2f(l2 - mx);
        const float inv = 1.0f / (w0 + w1 + w2); w0 *= inv; w1 *= inv; w2 *= inv;
        f32x4 a0, a1, b0, b1, c0, c1, z0, z1;
        unpack8(*(const u32x4*)(Og + ((size_t)0 * NTOK + tok) * 1024 + cc * 8), a0, a1);
        unpack8(*(const u32x4*)(Og + ((size_t)1 * NTOK + tok) * 1024 + cc * 8), b0, b1);
        unpack8(*(const u32x4*)(Og + ((size_t)2 * NTOK + tok) * 1024 + cc * 8), c0, c1);
        unpack8(*(const u32x4*)(H + (size_t)tok * HW + 9216 + cc * 8), z0, z1);
        *(u32x4*)(Y + (size_t)tok * 2048 + cc * 8) = pack8((a0 * w0 + b0 * w1 + c0 * w2) * z0, (a1 * w0 + b1 * w1 + c1 * w2) * z1);
    }
}
__device__ __forceinline__ float wave_sum(float v) {
#pragma unroll
    for (int o = 1; o < 64; o <<= 1) v += __shfl_xor(v, o);
    return v;
}

struct Args { const float* x; const float* w_in; const float* b_gate; const float* w_pool; const float* pool_scale; const float* w_pa; const float* w_pp; const float* w_out; const float* gamma; const float* beta; float* out; unsigned char* ws; };

__global__ void __launch_bounds__(NTHREADS, 2) hybrid_fwd(Args a) {
    extern __shared__ __attribute__((aligned(16))) unsigned char lds_raw[];
    LAS unsigned char* lds = (LAS unsigned char*)lds_raw;
    cg::grid_group grid = cg::this_grid();
    const int tid = threadIdx.x, lane = tid & 63, wave = __builtin_amdgcn_readfirstlane(tid >> 6);
    const int G = gridDim.x, bx = blockIdx.x;
    const int gt = bx * NTHREADS + tid, NT = G * NTHREADS, gw = bx * 8 + wave, NGW = G * 8;
    unsigned char* ws = a.ws;
    bf16_t* WinT = (bf16_t*)(ws + WS_WINT); bf16_t* XB = (bf16_t*)(ws + WS_XB); bf16_t* WpT = (bf16_t*)(ws + WS_WPT); bf16_t* WoT = (bf16_t*)(ws + WS_WOT); bf16_t* WplT = (bf16_t*)(ws + WS_WPLT);
    float* Lse = (float*)(ws + WS_LSE); bf16_t* H = (bf16_t*)(ws + WS_H); bf16_t* Og = (bf16_t*)(ws + WS_OG); bf16_t* Pp = (bf16_t*)(ws + WS_PP); bf16_t* Y = (bf16_t*)(ws + WS_Y); bf16_t* Mg = (bf16_t*)(ws + WS_MG);

    if (PHMASK & 1) {
        LAS float* scr = (LAS float*)(lds + wave * 16384);
        constexpr int I_IN = (2048 / 64) * (16384 / 32), I_PA = (1024 / 64) * (2048 / 32), I_PP = I_PA, I_O = (2048 / 64) * (2048 / 32), I_PL = (256 / 64) * (256 / 32);
        constexpr int NITEMS = I_IN + I_PA + I_PP + I_O + 4 * I_PL;
        for (int it = gw; it < NITEMS; it += NGW) {
            int r = it;
            if (r < I_IN) { p0_transpose_item(a.w_in, 16384, WinT, 2048, 0, scr, r, lane); continue; } r -= I_IN;
            if (r < I_PA) { p0_transpose_item(a.w_pa, 2048, WpT, 2048, 0, scr, r, lane); continue; } r -= I_PA;
            if (r < I_PP) { p0_transpose_item(a.w_pp, 2048, WpT, 2048, 1024, scr, r, lane); continue; } r -= I_PP;
            if (r < I_O) { p0_transpose_item(a.w_out, 2048, WoT, 2048, 0, scr, r, lane); continue; } r -= I_O;
            const int gq = r / I_PL; p0_transpose_item(a.w_pool + (size_t)gq * 65536, 256, WplT + (size_t)gq * 65536, 256, 0, scr, r % I_PL, lane);
        }
        for (int it = gt; it < NTOK * DM / 8; it += NT) { const f32x4 v0 = *(const f32x4*)(a.x + (size_t)it * 8), v1 = *(const f32x4*)(a.x + (size_t)it * 8 + 4); *(u32x4*)(XB + (size_t)it * 8) = pack8(v0, v1); }
    }
    grid.sync();
    if (PHMASK & 2) {
        pg8::Gemm g{XB, WinT, NTOK, HW, DM, DM, DM, 0, 0}; pg8::StaticOrder S; S.init(NTOK, HW, G, bx);
        pg8::EpiH E{H, a.b_gate};
        pg8::gemm_phase<pg8::EpiH, pg8::StaticOrder, true, true>(lds, g, S, E);
    }
    grid.sync();
    if (PHMASK & 4) { for (int u = bx; u < 2 * 3 * 8 * 32; u += G) attn_unit(lds, H, Og, Lse, u); }
    if (PHMASK & 4) poolprep(H, Pp, gt, NT);
    grid.sync();
    if (PHMASK & 8) combine(H, Og, Lse, Y, gt, NT);
    if (PHMASK & 8) {
        pg8::Gemm g{Pp, WplT, NTOK, 1024, 256, 1024, 256, 512, 0}; pg8::StaticOrder S; S.init(NTOK, 1024, G, bx);
        pg8::EpiPool E{H, a.pool_scale, Y};
        pg8::gemm_phase<pg8::EpiPool, pg8::StaticOrder, true, true>(lds, g, S, E);
    }
    grid.sync();
    if (PHMASK & 16) {
        pg8::Gemm g{Y, WpT, NTOK, DM, 1024, DM, DM, 0, 2048}; pg8::HalfOrder S; S.init(NTOK, DM, G, bx);
        pg8::EpiMerge E{H, Mg};
        pg8::gemm_phase<pg8::EpiMerge, pg8::HalfOrder, true, true>(lds, g, S, E);
    }
    grid.sync();
    if (PHMASK & 32) {
        pg8::Gemm g{Mg, WoT, NTOK, DM, DM, DM, DM, 0, 0}; pg8::StaticOrder S; S.init(NTOK, DM, G, bx);
        pg8::EpiOut E{a.x, a.out, ALPHA};
        pg8::gemm_phase<pg8::EpiOut, pg8::StaticOrder, true, true>(lds, g, S, E);
    }
    grid.sync();
    if (PHMASK & 64) for (int row = gw; row < NTOK; row += NGW) {
        float* rp = a.out + (size_t)row * DM + 4 * lane;
        f32x4 v[8]; float s = 0.f;
#pragma unroll
        for (int j = 0; j < 8; ++j) { v[j] = *(const f32x4*)(rp + 256 * j); s += (v[j][0] + v[j][1]) + (v[j][2] + v[j][3]); }
        const float mean = wave_sum(s) * (1.0f / DM); float q = 0.f;
#pragma unroll
        for (int j = 0; j < 8; ++j) { v[j] = v[j] - mean; q += (v[j][0] * v[j][0] + v[j][1] * v[j][1]) + (v[j][2] * v[j][2] + v[j][3] * v[j][3]); }
        const float rstd = 1.0f / sqrtf(wave_sum(q) * (1.0f / DM) + LN_EPS);
#pragma unroll
        for (int j = 0; j < 8; ++j) { const f32x4 gm = *(const f32x4*)(a.gamma + 4 * lane + 256 * j), bt = *(const f32x4*)(a.beta + 4 * lane + 256 * j); *(f32x4*)(rp + 256 * j) = v[j] * rstd * gm + bt; }
    }
}

extern "C" void kernel_launch(void* const* d_in, const int* in_sizes, int n_in, void* d_out, int out_size, void* d_ws, size_t ws_size, hipStream_t stream) {
    static int grid = 0;
    if (grid == 0) {
        if (n_in != 10 || in_sizes[0] != NTOK * DM || out_size != NTOK * DM || ws_size < WS_END) { fprintf(stderr, "kernel_launch: unexpected shapes / workspace (n_in %d, in0 %d, out %d, ws %zu)\n", n_in, n_in > 0 ? in_sizes[0] : -1, out_size, ws_size); grid = -1; return; }
        int dev = 0, cus = 0, per_cu = 0;
        if (hipGetDevice(&dev) != hipSuccess || hipDeviceGetAttribute(&cus, hipDeviceAttributeMultiprocessorCount, dev) != hipSuccess) { grid = -1; return; }
        if (hipFuncSetAttribute((const void*)hybrid_fwd, hipFuncAttributeMaxDynamicSharedMemorySize, LDS_BYTES) != hipSuccess) { fprintf(stderr, "kernel_launch: hipFuncSetAttribute failed\n"); grid = -1; return; }
        if (hipOccupancyMaxActiveBlocksPerMultiprocessor(&per_cu, (const void*)hybrid_fwd, NTHREADS, LDS_BYTES) != hipSuccess || per_cu < 1) { fprintf(stderr, "kernel_launch: occupancy query says %d blocks per CU\n", per_cu); (void)hipGetLastError(); grid = -1; return; }
        grid = cus * 1;
        if (grid % 8 != 0) { fprintf(stderr, "kernel_launch: grid %d not a multiple of 8\n", grid); }
    }
    if (grid < 0) return;
    Args a{};
    a.x = (const float*)d_in[0]; a.w_in = (const float*)d_in[1]; a.b_gate = (const float*)d_in[2]; a.w_pool = (const float*)d_in[3]; a.pool_scale = (const float*)d_in[4];
    a.w_pa = (const float*)d_in[5]; a.w_pp = (const float*)d_in[6]; a.w_out = (const float*)d_in[7]; a.gamma = (const float*)d_in[8]; a.beta = (const float*)d_in[9];
    a.out = (float*)d_out; a.ws = (unsigned char*)d_ws;
    void* args[] = {&a};
    hipError_t e = hipLaunchCooperativeKernel((const void*)hybrid_fwd, dim3(grid), dim3(NTHREADS), args, LDS_BYTES, stream);
    if (e != hipSuccess) fprintf(stderr, "kernel_launch: cooperative launch failed: %s (grid %d)\n", hipGetErrorString(e), grid);
}
```

```cpp
#include <hip/hip_runtime.h>
#include <hip/hip_cooperative_groups.h>
#include <cstdio>
#include <cstdint>
namespace cg = cooperative_groups;

namespace pg8 {
#define PG8_LAS __attribute__((address_space(3)))
typedef unsigned short bf16_t;
typedef short bf16x8 __attribute__((ext_vector_type(8)));
typedef float f32x4 __attribute__((ext_vector_type(4)));
typedef unsigned u32x4 __attribute__((ext_vector_type(4)));
constexpr int BM = 256, BK = 64, HALF = 128, HTB = HALF * BK * 2  , STAGE_BYTES = 8 * HTB, NXCD = 8, WGM = 8;

__host__ __device__ __forceinline__ int lds_byte(int r, int c) { const int st = (r >> 4) * 2 + (c >> 5), rr = r & 15, cc = c & 31, ob = rr * 64 + cc * 2; return st * 1024 + (ob ^ (((ob >> 9) & 1) << 5)); }
__host__ __device__ __forceinline__ void stage_rc(int b, int& R, int& C) { const int st = b / 1024, sb = b % 1024, swz = sb ^ (((sb >> 9) & 1) << 5); R = (st >> 1) * 16 + swz / 64; C = (st & 1) * 32 + (swz % 64) / 2; }
__host__ __device__ __forceinline__ int perm32(int rho) { const int n = rho >> 4, i = rho & 15; return 8 * (i >> 2) + 4 * n + (i & 3); }

struct Unit { int pm, pn, pk; };
struct Gemm { const bf16_t* A; const bf16_t* Bt; int M, N, K, lda, ldb, a_pn_off, kpart; };

struct StaticOrder {
    int nM, nN, nwg, G, c;
    __host__ __device__ void init(int M, int N, int G_, int c_) { nM = M / BM; nN = N / BM; nwg = nM * nN; G = G_; c = c_; }
    __host__ __device__ bool next(int i, Unit& u) const {
        const long L = (long)i * G + c; if (L >= nwg) return false;
        int wgid = (int)L; { const int q = nwg / NXCD, r = nwg % NXCD, xcd = wgid % NXCD, off = wgid / NXCD; wgid = (xcd < r ? xcd * (q + 1) : r * (q + 1) + (xcd - r) * q) + off; }
        const int nig = WGM * nN, gid = wgid / nig, fm = gid * WGM, gsz = (nM - fm) < WGM ? (nM - fm) : WGM;
        u.pm = fm + ((wgid % nig) % gsz); u.pn = (wgid % nig) / gsz; u.pk = 0; return true;
    }
    __device__ __forceinline__ void a_ready(const Unit&) const {}
    __device__ __forceinline__ void done(const Unit&) const {}
};
struct HalfOrder {
    StaticOrder base;
    __host__ __device__ void init(int M, int N, int G_, int c_) { base.init(M, N, G_, c_); }
    __host__ __device__ bool next(int i, Unit& u) const { if (!base.next(i >> 1, u)) return false; u.pk = i & 1; return true; }
    __device__ __forceinline__ void a_ready(const Unit&) const {}
    __device__ __forceinline__ void done(const Unit&) const {}
};

template <class Epi, class Sched, bool ALIGN_EPI = false, bool SP2 = false>
__device__ __forceinline__ void gemm_phase(PG8_LAS unsigned char* lds, const Gemm g, const Sched& S, const Epi& E) {
    const int tid = threadIdx.x, wid = __builtin_amdgcn_readfirstlane(tid >> 6), lane = tid & 63, wr = wid >> 2, wc = wid & 3, fr = lane & 15, fq = lane >> 4;
    const int K = g.K, nt = K / BK;
    unsigned voffA[2], voffB[2];
#pragma unroll
    for (int i = 0; i < 2; ++i) { int R, C; stage_rc(tid * 16 + i * 8192, R, C); const int Rb = Epi::PERM ? ((R & ~31) + perm32(R & 31)) : R;
        voffA[i] = (unsigned)(R * g.lda + C) * 2u; voffB[i] = (unsigned)(Rb * g.ldb + C) * 2u; }
    const size_t kstep = (size_t)(BK * 2);
    const size_t hstepA = (size_t)HALF * g.lda * 2, hstepB = (size_t)HALF * g.ldb * 2;
    const size_t tstepA = 2 * hstepA, tstepB = 2 * hstepB;
    const unsigned ldsw = (unsigned)wid * 1024u;
    const int aoff = lds_byte(wr * 64 + fr, fq * 8), boff = lds_byte(wc * 32 + fr, fq * 8);
#define PG8_SA(b, h) (((b) * 2 + (h)) * HTB)
#define PG8_SB(b, h) ((4 + (b) * 2 + (h)) * HTB)
#define PG8_STAGE(bufoff, gbase, voff) do { _Pragma("unroll") for (int _i = 0; _i < 2; ++_i) \
        __builtin_amdgcn_global_load_lds((const unsigned*)((const char*)(gbase) + (voff)[_i]), (PG8_LAS unsigned*)(lds + (bufoff) + ldsw + _i * 8192), 16, 0, 0); } while (0)
#define PG8_LDA(dst, b, h) do { _Pragma("unroll") for (int m = 0; m < 4; ++m) _Pragma("unroll") for (int k = 0; k < 2; ++k) dst[m][k] = *(const PG8_LAS bf16x8*)(lds + PG8_SA(b, h) + aoff + m * 2048 + k * 1024); } while (0)
#define PG8_LDB(dst, b, h) do { _Pragma("unroll") for (int n = 0; n < 2; ++n) _Pragma("unroll") for (int k = 0; k < 2; ++k) dst[n][k] = *(const PG8_LAS bf16x8*)(lds + PG8_SB(b, h) + boff + n * 2048 + k * 1024); } while (0)
#define PG8_MMA(ai, bj, At, Bt) do { __builtin_amdgcn_s_setprio(1); _Pragma("unroll") for (int m = 0; m < 4; ++m) _Pragma("unroll") for (int n = 0; n < 2; ++n) _Pragma("unroll") for (int k = 0; k < 2; ++k) \
        acc[ai][bj][m][n] = __builtin_amdgcn_mfma_f32_16x16x32_bf16(Bt[n][k], At[m][k], acc[ai][bj][m][n], 0, 0, 0); __builtin_amdgcn_s_setprio(0); } while (0)
#define PG8_WAIT_V(n) asm volatile("s_waitcnt vmcnt(" #n ")" ::: "memory")
#define PG8_WAIT_L(n) asm volatile("s_waitcnt lgkmcnt(" #n ")" ::: "memory")
#define PG8_BAR __builtin_amdgcn_s_barrier()
#define PG8_SCHED __builtin_amdgcn_sched_barrier(0)
    Unit cur, nxt; int ui = 0;
    if (!S.next(0, cur)) return;
    f32x4 acc[2][2][4][2];
#pragma unroll
    for (int a = 0; a < 2; ++a)
#pragma unroll
        for (int b = 0; b < 2; ++b)
#pragma unroll
            for (int m = 0; m < 4; ++m)
#pragma unroll
                for (int n = 0; n < 2; ++n) acc[a][b][m][n] = (f32x4){0.f, 0.f, 0.f, 0.f};
    bf16x8 At[4][2], B0[2][2], B1[2][2];
    const char* cA = (const char*)g.A + (size_t)cur.pm * tstepA + (size_t)cur.pn * g.a_pn_off + (size_t)cur.pk * g.kpart; const char* cB = (const char*)g.Bt + (size_t)cur.pn * tstepB + (size_t)cur.pk * g.kpart;
    S.a_ready(cur);
    if constexpr (SP2) {
        PG8_STAGE(PG8_SB(0, 0), cB, voffB); PG8_STAGE(PG8_SB(0, 1), cB + hstepB, voffB); PG8_STAGE(PG8_SA(0, 0), cA, voffA); PG8_STAGE(PG8_SA(0, 1), cA + hstepA, voffA);
        if (wr == 1) PG8_BAR;
        PG8_WAIT_V(2); PG8_BAR;
        PG8_STAGE(PG8_SB(1, 0), cB + kstep, voffB); PG8_STAGE(PG8_SA(1, 0), cA + kstep, voffA); PG8_STAGE(PG8_SB(1, 1), cB + hstepB + kstep, voffB);
        PG8_WAIT_V(6); PG8_BAR;
    } else {
        PG8_STAGE(PG8_SB(0, 0), cB, voffB); PG8_STAGE(PG8_SA(0, 0), cA, voffA); PG8_STAGE(PG8_SB(0, 1), cB + hstepB, voffB); PG8_STAGE(PG8_SA(0, 1), cA + hstepA, voffA);
        if (wr == 1) PG8_BAR;
        PG8_WAIT_V(4); PG8_BAR;
        PG8_STAGE(PG8_SB(1, 0), cB + kstep, voffB); PG8_STAGE(PG8_SA(1, 0), cA + kstep, voffA); PG8_STAGE(PG8_SB(1, 1), cB + hstepB + kstep, voffB);
        PG8_WAIT_V(6); PG8_BAR;
    }
    for (;;) {
        const bool has_next = S.next(ui + 1, nxt);
        const char* nA = has_next ? (const char*)g.A + (size_t)nxt.pm * tstepA + (size_t)nxt.pn * g.a_pn_off + (size_t)nxt.pk * g.kpart : cA; const char* nB = has_next ? (const char*)g.Bt + (size_t)nxt.pn * tstepB + (size_t)nxt.pk * g.kpart : cB;
#pragma nounroll
        for (int t = 0; t < nt; t += 2) {
            const bool last = (t == nt - 2);
            const char* a1 = cA + (size_t)(t + 1) * kstep;
            const char* a2 = last ? nA : cA + (size_t)(t + 2) * kstep; const char* b2 = last ? nB : cB + (size_t)(t + 2) * kstep;
            const char* a3 = a2 + kstep; const char* b3 = b2 + kstep;
            if (last && has_next) S.a_ready(nxt);
            if constexpr (SP2) {
            PG8_LDB(B0, 0, 0); PG8_LDB(B1, 0, 1); PG8_SCHED; PG8_LDA(At, 0, 0); PG8_STAGE(PG8_SA(1, 1), a1 + hstepA, voffA);
            PG8_WAIT_V(8); PG8_WAIT_L(0); PG8_BAR; PG8_MMA(0, 0, At, B0); PG8_MMA(0, 1, At, B1); PG8_BAR; PG8_SCHED;
            PG8_LDA(At, 0, 1); PG8_STAGE(PG8_SB(0, 0), b2, voffB); PG8_STAGE(PG8_SB(0, 1), b2 + hstepB, voffB); PG8_STAGE(PG8_SA(0, 0), a2, voffA);
            PG8_WAIT_V(8); PG8_WAIT_L(0); PG8_BAR; PG8_MMA(1, 0, At, B0); PG8_MMA(1, 1, At, B1); PG8_BAR; PG8_SCHED;
            PG8_LDB(B0, 1, 0); PG8_LDB(B1, 1, 1); PG8_SCHED; PG8_LDA(At, 1, 0); PG8_STAGE(PG8_SA(0, 1), a2 + hstepA, voffA);
            PG8_WAIT_V(8); PG8_WAIT_L(0); PG8_BAR; PG8_MMA(0, 0, At, B0); PG8_MMA(0, 1, At, B1); PG8_BAR; PG8_SCHED;
            PG8_LDA(At, 1, 1); PG8_STAGE(PG8_SB(1, 0), b3, voffB); PG8_STAGE(PG8_SB(1, 1), b3 + hstepB, voffB); PG8_STAGE(PG8_SA(1, 0), a3, voffA);
            PG8_WAIT_V(8); PG8_WAIT_L(0); PG8_BAR; PG8_MMA(1, 0, At, B0); PG8_MMA(1, 1, At, B1); PG8_BAR; PG8_SCHED;
            } else {
            PG8_LDB(B0, 0, 0); PG8_SCHED; PG8_LDA(At, 0, 0); PG8_STAGE(PG8_SA(1, 1), a1 + hstepA, voffA);
            PG8_WAIT_L(8); PG8_BAR; PG8_WAIT_L(0); PG8_MMA(0, 0, At, B0); PG8_BAR; PG8_SCHED;
            PG8_LDB(B1, 0, 1); PG8_STAGE(PG8_SB(0, 0), b2, voffB);
            PG8_BAR; PG8_WAIT_L(0); PG8_MMA(0, 1, At, B1); PG8_BAR;
            PG8_LDA(At, 0, 1); PG8_STAGE(PG8_SA(0, 0), a2, voffA);
            PG8_BAR; PG8_WAIT_L(0); PG8_MMA(1, 0, At, B0); PG8_BAR; PG8_SCHED;
            PG8_STAGE(PG8_SB(0, 1), b2 + hstepB, voffB);
            PG8_WAIT_V(6); PG8_BAR; PG8_MMA(1, 1, At, B1); PG8_BAR;
            PG8_LDB(B0, 1, 0); PG8_SCHED; PG8_LDA(At, 1, 0); PG8_STAGE(PG8_SA(0, 1), a2 + hstepA, voffA);
            PG8_WAIT_L(8); PG8_BAR; PG8_WAIT_L(0); PG8_MMA(0, 0, At, B0); PG8_BAR; PG8_SCHED;
            PG8_LDB(B1, 1, 1); PG8_STAGE(PG8_SB(1, 0), b3, voffB);
            PG8_BAR; PG8_WAIT_L(0); PG8_MMA(0, 1, At, B1); PG8_BAR;
            PG8_LDA(At, 1, 1); PG8_STAGE(PG8_SA(1, 0), a3, voffA);
            PG8_BAR; PG8_WAIT_L(0); PG8_MMA(1, 0, At, B0); PG8_BAR; PG8_SCHED;
            PG8_STAGE(PG8_SB(1, 1), b3 + hstepB, voffB);
            PG8_WAIT_V(6); PG8_BAR; PG8_MMA(1, 1, At, B1); PG8_BAR;
            }
        }
        if constexpr (ALIGN_EPI) { if (wr == 0) PG8_BAR; }
        if constexpr (!Epi::AFTER_DRAIN) { E(acc, cur, wr, wc, fr, fq); S.done(cur); }
        if (!has_next) break;
        if (!(Epi::MIDK && cur.pk == 0))
#pragma unroll
        for (int a = 0; a < 2; ++a)
#pragma unroll
            for (int b = 0; b < 2; ++b)
#pragma unroll
                for (int m = 0; m < 4; ++m)
#pragma unroll
                    for (int n = 0; n < 2; ++n) acc[a][b][m][n] = (f32x4){0.f, 0.f, 0.f, 0.f};
        cur = nxt; cA = nA; cB = nB; ++ui;
        if constexpr (ALIGN_EPI) { if (wr == 1) PG8_BAR; }
    }
    PG8_WAIT_V(0);
    if constexpr (!ALIGN_EPI) { if (wr == 0) PG8_BAR; }
    PG8_BAR;
    if constexpr (Epi::AFTER_DRAIN) { E.fused(acc, cur, wr, wc, fr, fq, lds, wid, lane); S.done(cur); }
#undef PG8_SA
#undef PG8_SB
#undef PG8_STAGE
#undef PG8_LDA
#undef PG8_LDB
#undef PG8_MMA
#undef PG8_WAIT_V
#undef PG8_WAIT_L
#undef PG8_BAR
#undef PG8_SCHED
}
}

namespace pg8 {
typedef float f32x2_t __attribute__((ext_vector_type(2))); typedef __bf16 bf16x2_t __attribute__((ext_vector_type(2)));
__device__ __forceinline__ unsigned cvtpk(float lo, float hi) { f32x2_t v = {lo, hi}; bf16x2_t b = __builtin_convertvector(v, bf16x2_t); return __builtin_bit_cast(unsigned, b); }
__device__ __forceinline__ float bf_lo(unsigned w) { return __uint_as_float(w << 16); }
__device__ __forceinline__ float bf_hi(unsigned w) { return __uint_as_float(w & 0xffff0000u); }
__device__ __forceinline__ float sigmoidf_(float v) { return __builtin_amdgcn_rcpf(1.0f + __builtin_amdgcn_exp2f(-1.4426950408889634f * v)); }
__device__ __forceinline__ u32x4 pack8(const f32x4& a, const f32x4& b) { u32x4 w; w.x = cvtpk(a[0], a[1]); w.y = cvtpk(a[2], a[3]); w.z = cvtpk(b[0], b[1]); w.w = cvtpk(b[2], b[3]); return w; }
__device__ __forceinline__ void unpack8(const u32x4& w, f32x4& a, f32x4& b) { a = (f32x4){bf_lo(w.x), bf_hi(w.x), bf_lo(w.y), bf_hi(w.y)}; b = (f32x4){bf_lo(w.z), bf_hi(w.z), bf_lo(w.w), bf_hi(w.w)}; }

constexpr int HW = 16384;
constexpr float QSCALE = 0.08838834764831845f * 1.4426950408889634f;
struct EpiH {
    static constexpr bool PERM = true, AFTER_DRAIN = false, MIDK = false;
    bf16_t* H; const float* b_gate;
    __device__ __forceinline__ void operator()(const f32x4 (&acc)[2][2][4][2], const Unit& u, int wr, int wc, int fr, int fq) const {
        const int colt = u.pn * BM, row0 = u.pm * BM + wr * 64 + fr, col0 = colt + wc * 32 + 8 * fq;
        const int mode = colt < 3072 ? 1 : (colt < 9216 ? 0 : (colt < 10240 ? 2 : (colt < 11264 ? 0 : (colt < 12288 ? 2 : 3))));
        f32x4 bv[2][2];
#pragma unroll
        for (int bj = 0; bj < 2; ++bj)
#pragma unroll
            for (int n = 0; n < 2; ++n) bv[bj][n] = (mode == 3) ? *(const f32x4*)(b_gate + (col0 - 12288) + bj * HALF + 4 * n) : (f32x4){0.f, 0.f, 0.f, 0.f};
#pragma unroll
        for (int ai = 0; ai < 2; ++ai)
#pragma unroll
            for (int m = 0; m < 4; ++m) { bf16_t* rowp = H + (size_t)(row0 + ai * HALF + m * 16) * HW + col0;
#pragma unroll
                for (int bj = 0; bj < 2; ++bj) { f32x4 v0 = acc[ai][bj][m][0], v1 = acc[ai][bj][m][1];
                    if (mode == 1) { v0 = v0 * QSCALE; v1 = v1 * QSCALE; }
                    else if (mode == 2) {
#pragma unroll
                        for (int e = 0; e < 4; ++e) { v0[e] = v0[e] * sigmoidf_(v0[e]); v1[e] = v1[e] * sigmoidf_(v1[e]); } }
                    else if (mode == 3) { v0 = v0 + bv[bj][0]; v1 = v1 + bv[bj][1];
#pragma unroll
                        for (int e = 0; e < 4; ++e) { v0[e] = sigmoidf_(v0[e]); v1[e] = sigmoidf_(v1[e]); } }
                    *(u32x4*)(rowp + bj * HALF) = pack8(v0, v1); } }
    }
};
struct EpiPool {
    static constexpr bool PERM = true, AFTER_DRAIN = false, MIDK = false;
    const bf16_t* H; const float* pool_scale; bf16_t* Y;
    __device__ __forceinline__ void operator()(const f32x4 (&acc)[2][2][4][2], const Unit& u, int wr, int wc, int fr, int fq) const {
        const int row0 = u.pm * BM + wr * 64 + fr, col0 = u.pn * BM + wc * 32 + 8 * fq;
#pragma unroll
        for (int bj = 0; bj < 2; ++bj) { const int col = col0 + bj * HALF;
            const f32x4 s0 = *(const f32x4*)(pool_scale + col), s1 = *(const f32x4*)(pool_scale + col + 4);
#pragma unroll
            for (int ai = 0; ai < 2; ++ai)
#pragma unroll
                for (int m = 0; m < 4; ++m) { const size_t row = (size_t)(row0 + ai * HALF + m * 16);
                    f32x4 z0, z1; unpack8(*(const u32x4*)(H + row * HW + 11264 + col), z0, z1);
                    *(u32x4*)(Y + row * 2048 + 1024 + col) = pack8(acc[ai][bj][m][0] * s0 * z0, acc[ai][bj][m][1] * s1 * z1);
                    if (m & 1) asm volatile("" ::: "memory"); } }
    }
};
struct EpiMerge {
    static constexpr bool PERM = true, AFTER_DRAIN = false, MIDK = true;
    const bf16_t* H; bf16_t* Mg;
    __device__ __forceinline__ void operator()(f32x4 (&acc)[2][2][4][2], const Unit& u, int wr, int wc, int fr, int fq) const {
        const int row0 = u.pm * BM + wr * 64 + fr, col0 = u.pn * BM + wc * 32 + 8 * fq;
        if (u.pk == 0) {
#pragma unroll
        for (int ai = 0; ai < 2; ++ai)
#pragma unroll
            for (int m = 0; m < 4; ++m) { const bf16_t* hp = H + (size_t)(row0 + ai * HALF + m * 16) * HW + 12288 + col0;
#pragma unroll
                for (int bj = 0; bj < 2; ++bj) { f32x4 a0, a1, p0, p1; unpack8(*(const u32x4*)(hp + bj * HALF), a0, a1); unpack8(*(const u32x4*)(hp + 2048 + bj * HALF), p0, p1);
#pragma unroll
                    for (int e = 0; e < 4; ++e) { acc[ai][bj][m][0][e] *= a0[e] * __builtin_amdgcn_rcpf(p0[e]); acc[ai][bj][m][1][e] *= a1[e] * __builtin_amdgcn_rcpf(p1[e]); } } }
        } else {
#pragma unroll
        for (int ai = 0; ai < 2; ++ai)
#pragma unroll
            for (int m = 0; m < 4; ++m) { const size_t row = (size_t)(row0 + ai * HALF + m * 16);
#pragma unroll
                for (int bj = 0; bj < 2; ++bj) { const int col = col0 + bj * HALF; f32x4 p0, p1; unpack8(*(const u32x4*)(H + row * HW + 14336 + col), p0, p1);
                    *(u32x4*)(Mg + row * 2048 + col) = pack8(acc[ai][bj][m][0] * p0, acc[ai][bj][m][1] * p1); } }
        }
    }
};
struct EpiOut {
    static constexpr bool PERM = true, AFTER_DRAIN = false, MIDK = false;
    const float* x; float* out; float alpha;
    __device__ __forceinline__ void operator()(const f32x4 (&acc)[2][2][4][2], const Unit& u, int wr, int wc, int fr, int fq) const {
        const int row0 = u.pm * BM + wr * 64 + fr, col0 = u.pn * BM + wc * 32 + 8 * fq;
#pragma unroll
        for (int ai = 0; ai < 2; ++ai)
#pragma unroll
            for (int m = 0; m < 4; ++m) { const size_t off = (size_t)(row0 + ai * HALF + m * 16) * 2048 + col0;
#pragma unroll
                for (int bj = 0; bj < 2; ++bj)
#pragma unroll
                    for (int n = 0; n < 2; ++n) { const f32x4 xv = *(const f32x4*)(x + off + bj * HALF + 4 * n); *(f32x4*)(out + off + bj * HALF + 4 * n) = xv * alpha + acc[ai][bj][m][n]; } }
    }
};
}

#define LAS __attribute__((address_space(3)))
typedef unsigned short bf16_t;
typedef short bf16x8 __attribute__((ext_vector_type(8)));
typedef short s16x4 __attribute__((ext_vector_type(4)));
typedef float f32x4 __attribute__((ext_vector_type(4)));
typedef unsigned u32x4 __attribute__((ext_vector_type(4)));
typedef unsigned u32x2 __attribute__((ext_vector_type(2)));
using pg8::cvtpk; using pg8::pack8; using pg8::unpack8;

constexpr int SEQ = 4096, NTOK = 8192, DM = 2048, HW = 16384, NTHREADS = 512;
constexpr size_t MiB = 1u << 20;
constexpr size_t WS_WINT = 0, WS_XB = 64 * MiB, WS_WPT = 96 * MiB, WS_WOT = 104 * MiB, WS_WPLT = 112 * MiB, WS_LSE = 113 * MiB, WS_H = 128 * MiB, WS_END = 384 * MiB;
constexpr size_t WS_BAR = 114 * MiB;
constexpr int MISC_OFF = 131072;
constexpr size_t WS_OG = 0, WS_PP = 48 * MiB, WS_Y = 64 * MiB, WS_MG = 0;
constexpr int LDS_BYTES = 147456;
constexpr int LDS_KOFF = 0, LDS_VOFF = 65536;
constexpr float LN_EPS = 1e-5f;
#ifndef PHMASK
#define PHMASK 0x7f
#endif
#define DUPMASK 0
#define NREP(k) (1 + ((DUPMASK >> (k)) & 1))
#define GSYNC() do { xcd_barrier(xbar); if (DUPMASK & 128) xcd_barrier(xbar); } while (0)
constexpr float ALPHA = 1.189207115002721f;

__device__ __forceinline__ void p0_transpose_item(const float* __restrict__ W, int N, bf16_t* __restrict__ WT, int ldo, int koff, LAS float* scr, int item, int lane) {
    const int nblk = N / 32, kb = item / nblk, nb = item % nblk, k0 = 64 * kb, n0 = 32 * nb;
#pragma unroll 8
    for (int i = 0; i < 32; ++i) { const int kk = 2 * i + (lane >> 5); scr[kk * 33 + (lane & 31)] = W[(size_t)(k0 + kk) * N + n0 + (lane & 31)]; }
    asm volatile("s_waitcnt lgkmcnt(0)" ::: "memory");
    const int c = lane & 7;
#pragma unroll
    for (int j = 0; j < 4; ++j) { const int n = (lane >> 3) + 8 * j; const LAS float* s = scr + (8 * c) * 33 + n;
        u32x4 o; o.x = cvtpk(s[0 * 33], s[1 * 33]); o.y = cvtpk(s[2 * 33], s[3 * 33]); o.z = cvtpk(s[4 * 33], s[5 * 33]); o.w = cvtpk(s[6 * 33], s[7 * 33]);
        *(u32x4*)(WT + (size_t)(n0 + n) * ldo + koff + k0 + 8 * c) = o; }
    asm volatile("s_waitcnt lgkmcnt(0)" ::: "memory");
}

__device__ __forceinline__ unsigned offk(int row, int ch) { return (unsigned)(row * 256 + 16 * (ch ^ (row & 15))); }
__device__ __forceinline__ unsigned offv(int row, int ch) { return (unsigned)(row * 256 + 16 * (ch ^ (((row & 3) << 2) | ((row >> 2) & 3)))); }
typedef short v4i16_t __attribute__((ext_vector_type(4)));
__device__ __forceinline__ s16x4 vtr(LAS unsigned char* p) { return __builtin_bit_cast(s16x4, __builtin_amdgcn_ds_read_tr16_b64_v4i16((LAS v4i16_t*)p)); }
#define MFMA16(a, b, c) __builtin_amdgcn_mfma_f32_16x16x32_bf16((a), (b), (c), 0, 0, 0)

__device__ __forceinline__ void attn_unit(LAS unsigned char* lds, const bf16_t* __restrict__ H, bf16_t* __restrict__ Og, float* __restrict__ Lse, int unit) {
    const int tid = threadIdx.x, lane = tid & 63, wid = __builtin_amdgcn_readfirstlane(tid >> 6);
    const int blk = unit & 31, h = (unit >> 5) & 7, bg = unit >> 8, g = bg % 3, b = bg / 3;
    const int dsh = 2 * g, dil = 1 << dsh, r = blk & (dil - 1), n = blk >> dsh;
    const size_t tok0 = (size_t)b * SEQ + r;
    const int qcol = g * 1024 + h * 128;
    const int ql = lane & 15, g4 = lane >> 4;
    const int qi = 16 * wid + ql;
    const size_t qtok = tok0 + ((size_t)(n * 128 + qi) << dsh);
    bf16x8 qf[4];
    { const bf16_t* qp = H + qtok * HW + qcol + 8 * g4;
#pragma unroll
      for (int s = 0; s < 4; ++s) qf[s] = *(const bf16x8*)(qp + 32 * s); }
    {
        const int ch = tid & 15, r0 = tid >> 4;
        u32x4 kv[8], vv[8];
#pragma unroll
        for (int i = 0; i < 8; ++i) { const int row = r0 + 32 * i, j = (n - 1) * 128 + row;
            if (j >= 0) { const bf16_t* p = H + (tok0 + ((size_t)j << dsh)) * HW + 3072 + qcol + ch * 8; kv[i] = *(const u32x4*)p; vv[i] = *(const u32x4*)(p + 3072); }
            else { kv[i] = (u32x4){0u, 0u, 0u, 0u}; vv[i] = (u32x4){0u, 0u, 0u, 0u}; } }
#pragma unroll
        for (int i = 0; i < 8; ++i) { const int row = r0 + 32 * i;
            *(LAS u32x4*)(lds + LDS_KOFF + offk(row, ch)) = kv[i]; *(LAS u32x4*)(lds + LDS_VOFF + offv(row, ch)) = vv[i]; }
    }
    __syncthreads();
    f32x4 sc[9];
#pragma unroll
    for (int kt = 0; kt < 9; ++kt) { f32x4 a = (f32x4){0.f, 0.f, 0.f, 0.f}; const int krow = 16 * (wid + kt) + ql;
#pragma unroll
        for (int s = 0; s < 4; ++s) { const bf16x8 kf = *(const LAS bf16x8*)(lds + LDS_KOFF + offk(krow, 4 * s + g4)); a = MFMA16(kf, qf[s], a); }
        sc[kt] = a; }
    float mx = -INFINITY;
#pragma unroll
    for (int kt = 0; kt < 9; ++kt)
#pragma unroll
        for (int i = 0; i < 4; ++i) { const int dist = 16 * kt + 4 * g4 + i - ql, kj = 16 * (wid + kt) + 4 * g4 + i;
            const bool ok = (dist >= 0) && (dist <= 128) && (n > 0 || kj >= 128);
            const float v = ok ? sc[kt][i] : -INFINITY; sc[kt][i] = v; mx = fmaxf(mx, v); }
    mx = fmaxf(mx, __shfl_xor(mx, 16)); mx = fmaxf(mx, __shfl_xor(mx, 32));
    float l = 0.f;
#pragma unroll
    for (int kt = 0; kt < 9; ++kt)
#pragma unroll
        for (int i = 0; i < 4; ++i) { const float e = __builtin_amdgcn_exp2f(sc[kt][i] - mx); sc[kt][i] = e; l += e; }
    l += __shfl_xor(l, 16); l += __shfl_xor(l, 32);
    bf16x8 pf[5];
#pragma unroll
    for (int ks = 0; ks < 5; ++ks) { u32x4 w; w.x = cvtpk(sc[2 * ks][0], sc[2 * ks][1]); w.y = cvtpk(sc[2 * ks][2], sc[2 * ks][3]);
        if (2 * ks + 1 < 9) { w.z = cvtpk(sc[(2 * ks + 1) % 9][0], sc[(2 * ks + 1) % 9][1]); w.w = cvtpk(sc[(2 * ks + 1) % 9][2], sc[(2 * ks + 1) % 9][3]); } else { w.z = 0u; w.w = 0u; }
        pf[ks] = __builtin_bit_cast(bf16x8, w); }
    f32x4 o[8];
#pragma unroll
    for (int dt = 0; dt < 8; ++dt) o[dt] = (f32x4){0.f, 0.f, 0.f, 0.f};
    const int q4 = ql >> 2, p = ql & 3;
#pragma unroll
    for (int ks = 0; ks < 5; ++ks) { const int row0 = (16 * (wid + 2 * ks) + 4 * g4 + q4) & 255, row1 = (row0 + 16) & 255;
#pragma unroll
        for (int dt = 0; dt < 8; ++dt) { const int ch = 2 * dt + (p >> 1);
            const s16x4 lo = vtr(lds + LDS_VOFF + offv(row0, ch) + 8 * (p & 1)), hi = vtr(lds + LDS_VOFF + offv(row1, ch) + 8 * (p & 1));
            const bf16x8 vf = __builtin_shufflevector(lo, hi, 0, 1, 2, 3, 4, 5, 6, 7);
            o[dt] = MFMA16(vf, pf[ks], o[dt]); } }
    const float inv = 1.0f / l;
    bf16_t* op = Og + ((size_t)g * NTOK + qtok) * 1024 + h * 128 + 4 * g4;
#pragma unroll
    for (int dt = 0; dt < 8; ++dt) { u32x2 w; w.x = cvtpk(o[dt][0] * inv, o[dt][1] * inv); w.y = cvtpk(o[dt][2] * inv, o[dt][3] * inv); *(u32x2*)(op + 16 * dt) = w; }
    if (g4 == 0) Lse[((size_t)g * NTOK + qtok) * 8 + h] = mx + __builtin_amdgcn_logf(l);
    __syncthreads();
}

__device__ __forceinline__ void poolprep(const bf16_t* __restrict__ H, bf16_t* __restrict__ Pp, int gt, int NT) {
    for (int it = gt; it < NTOK * 128; it += NT) {
        const int tok = it >> 7, cc = it & 127, w = 2 << (cc >> 5), t = tok & (SEQ - 1), cnt = (t + 1 < w) ? t + 1 : w;
        const bf16_t* up = H + (size_t)tok * HW + 10240 + cc * 8;
        f32x4 s0 = (f32x4){0.f, 0.f, 0.f, 0.f}, s1 = s0, u0, u1;
        unpack8(*(const u32x4*)up, u0, u1); s0 = u0; s1 = u1;
        for (int k = 1; k < cnt; ++k) { f32x4 a, c; unpack8(*(const u32x4*)(up - (size_t)k * HW), a, c); s0 += a; s1 += c; }
        const float rc = 1.0f / (float)cnt;
        *(u32x4*)(Pp + (size_t)tok * 1024 + cc * 8) = pack8(s0 * rc - u0, s1 * rc - u1);
    }
}
__device__ __forceinline__ void combine(const bf16_t* __restrict__ H, const bf16_t* __restrict__ Og, const float* __restrict__ Lse, bf16_t* __restrict__ Y, int gt, int NT) {
    for (int it = gt; it < NTOK * 128; it += NT) {
        const int tok = it >> 7, cc = it & 127, hh = cc >> 4;
        const float l0 = Lse[((size_t)0 * NTOK + tok) * 8 + hh], l1 = Lse[((size_t)1 * NTOK + tok) * 8 + hh], l2 = Lse[((size_t)2 * NTOK + tok) * 8 + hh];
        const float mx = fmaxf(l0, fmaxf(l1, l2));
        float w0 = __builtin_amdgcn_exp2f(l0 - mx), w1 = __builtin_amdgcn_exp2f(l1 - mx), w2 = __builtin_amdgcn_exp2f(l2 - mx);
        const float inv = 1.0f / (w0 + w1 + w2); w0 *= inv; w1 *= inv; w2 *= inv;
        f32x4 a0, a1, b0, b1, c0, c1, z0, z1;
        unpack8(*(const u32x4*)(Og + ((size_t)0 * NTOK + tok) * 1024 + cc * 8), a0, a1);
        unpack8(*(const u32x4*)(Og + ((size_t)1 * NTOK + tok) * 1024 + cc * 8), b0, b1);
        unpack8(*(const u32x4*)(Og + ((size_t)2 * NTOK + tok) * 1024 + cc * 8), c0, c1);
        unpack8(*(const u32x4*)(H + (size_t)tok * HW + 9216 + cc * 8), z0, z1);
        *(u32x4*)(Y + (size_t)tok * 2048 + cc * 8) = pack8((a0 * w0 + b0 * w1 + c0 * w2) * z0, (a1 * w0 + b1 * w1 + c1 * w2) * z1);
    }
}
__device__ __forceinline__ float wave_sum(float v) {
#pragma unroll
    for (int o = 1; o < 64; o <<= 1) v += __shfl_xor(v, o);
    return v;
}

#define XB_TMO      128
#define XB_XCNT(j)  (256  + 64 * (j))
#define XB_XSUB(j)  (1280 + 64 * (j))
#define XB_XGEN(j)  (2304 + 64 * (j))
#define XB_TOP      3328
#define XB_TOPGEN   3392
#define XCD_BAR_WORDS 3456
#define XB_SPIN_CAP (1u << 18)

__device__ __forceinline__ unsigned xb_ld(unsigned* p)              { return __hip_atomic_load(p, __ATOMIC_RELAXED, __HIP_MEMORY_SCOPE_AGENT); }
__device__ __forceinline__ unsigned xb_add(unsigned* p, unsigned v) { return __hip_atomic_fetch_add(p, v, __ATOMIC_RELAXED, __HIP_MEMORY_SCOPE_AGENT); }
__device__ __forceinline__ unsigned xb_xcc_id() { return (unsigned)__builtin_amdgcn_s_getreg((3 << 11) | 20) & 0xFu; }
#define XB_SPIN(cond, bar) do { unsigned _sp = 0; while (cond) { __builtin_amdgcn_s_sleep(1); \
    if ((++_sp & 255u) == 0u) { if (xb_ld(&(bar)[XB_TMO])) break; if (_sp > XB_SPIN_CAP) { atomicAdd(&(bar)[XB_TMO], 1u); break; } } } } while (0)

struct XcdBarrier {
    unsigned* bar; unsigned x;
    volatile LAS unsigned* st;
};

__device__ __forceinline__ XcdBarrier xcd_barrier_post(unsigned* bar, volatile LAS unsigned* st) {
    XcdBarrier b; b.bar = bar; b.x = xb_xcc_id(); b.st = st;
    if (threadIdx.x == 0) (void)xb_add(&bar[XB_XCNT(b.x)], 1u);
    return b;
}
__device__ __forceinline__ void xcd_barrier_complete(unsigned* bar, unsigned x, unsigned& nloc, unsigned& nx) {
    const unsigned G = gridDim.x * gridDim.y * gridDim.z;
    unsigned sum, cnt, mine, sp = 0u;
    for (;;) {
        sum = 0u; cnt = 0u; mine = 0u;
#pragma unroll
        for (unsigned j = 0; j < 16; ++j) { const unsigned c = xb_ld(&bar[XB_XCNT(j)]); sum += c; cnt += (c > 0u) ? 1u : 0u; mine = (j == x) ? c : mine; }
        if (sum == G) break;
        __builtin_amdgcn_s_sleep(1);
        if ((++sp & 255u) == 0u) { if (xb_ld(&bar[XB_TMO])) break; if (sp > XB_SPIN_CAP) { atomicAdd(&bar[XB_TMO], 1u); break; } }
    }
    nloc = mine > 0u ? mine : 1u; nx = cnt > 0u ? cnt : 1u;
}

__device__ __forceinline__ void xcd_barrier(const XcdBarrier& b) {
    asm volatile("s_waitcnt vmcnt(0)" ::: "memory");
    __syncthreads();
    if (threadIdx.x == 0) {
        unsigned* bar = b.bar;
        __builtin_amdgcn_s_waitcnt(0);
        unsigned nloc = b.st[0], nx = b.st[1];
        if (nloc == 0u) { xcd_barrier_complete(bar, b.x, nloc, nx); b.st[0] = nloc; b.st[1] = nx; }
        const unsigned old = xb_add(&bar[XB_XSUB(b.x)], 1u);
        const unsigned gen = old / nloc;
        if (old + 1u == (gen + 1u) * nloc) {
            __builtin_amdgcn_fence(__ATOMIC_RELEASE, "agent");
            asm volatile("s_waitcnt vmcnt(0)" ::: "memory");
            const unsigned og = xb_add(&bar[XB_TOP], 1u);
            const unsigned tg = og / nx;
            if (og + 1u == (tg + 1u) * nx) xb_add(&bar[XB_TOPGEN], 1u);
            else XB_SPIN(xb_ld(&bar[XB_TOPGEN]) == tg, bar);
            __builtin_amdgcn_fence(__ATOMIC_ACQUIRE, "agent");
            xb_add(&bar[XB_XGEN(b.x)], 1u);
            asm volatile("s_waitcnt vmcnt(0)" ::: "memory");
        } else {
            XB_SPIN(xb_ld(&bar[XB_XGEN(b.x)]) == gen, bar);
            __builtin_amdgcn_fence(__ATOMIC_ACQUIRE, "agent");
            asm volatile("s_waitcnt vmcnt(0)" ::: "memory");
        }
    }
    __syncthreads();
}

struct Args { const float* x; const float* w_in; const float* b_gate; const float* w_pool; const float* pool_scale; const float* w_pa; const float* w_pp; const float* w_out; const float* gamma; const float* beta; float* out; unsigned char* ws; };

__global__ void __launch_bounds__(NTHREADS, 2) hybrid_fwd(Args a) {
    extern __shared__ __attribute__((aligned(16))) unsigned char lds_raw[];
    LAS unsigned char* lds = (LAS unsigned char*)lds_raw;
    cg::grid_group grid = cg::this_grid();
    const int tid = threadIdx.x, lane = tid & 63, wave = __builtin_amdgcn_readfirstlane(tid >> 6);
    const int G = gridDim.x, bx = blockIdx.x;
    const int gt = bx * NTHREADS + tid, NT = G * NTHREADS, gw = bx * 8 + wave, NGW = G * 8;
    unsigned char* ws = a.ws;
    bf16_t* WinT = (bf16_t*)(ws + WS_WINT); bf16_t* XB = (bf16_t*)(ws + WS_XB); bf16_t* WpT = (bf16_t*)(ws + WS_WPT); bf16_t* WoT = (bf16_t*)(ws + WS_WOT); bf16_t* WplT = (bf16_t*)(ws + WS_WPLT);
    float* Lse = (float*)(ws + WS_LSE); bf16_t* H = (bf16_t*)(ws + WS_H); bf16_t* Og = (bf16_t*)(ws + WS_OG); bf16_t* Pp = (bf16_t*)(ws + WS_PP); bf16_t* Y = (bf16_t*)(ws + WS_Y); bf16_t* Mg = (bf16_t*)(ws + WS_MG);

    unsigned* barw = (unsigned*)(ws + WS_BAR);
    volatile LAS unsigned* MISC = (volatile LAS unsigned*)(lds + MISC_OFF);
    if (tid < 32) MISC[tid] = 0u;
    if (bx == 0) for (int i = tid; i < XCD_BAR_WORDS; i += NTHREADS) __hip_atomic_store(barw + i, 0u, __ATOMIC_RELAXED, __HIP_MEMORY_SCOPE_AGENT);
    __syncthreads();
    for (int rep_ = 0; rep_ < NREP(0); ++rep_) if (PHMASK & 1) {
        LAS float* scr = (LAS float*)(lds + wave * 16384);
        constexpr int I_IN = (2048 / 64) * (16384 / 32), I_PA = (1024 / 64) * (2048 / 32), I_PP = I_PA, I_O = (2048 / 64) * (2048 / 32), I_PL = (256 / 64) * (256 / 32);
        constexpr int NITEMS = I_IN + I_PA + I_PP + I_O + 4 * I_PL;
        for (int it = gw; it < NITEMS; it += NGW) {
            int r = it;
            if (r < I_IN) { p0_transpose_item(a.w_in, 16384, WinT, 2048, 0, scr, r, lane); continue; } r -= I_IN;
            if (r < I_PA) { p0_transpose_item(a.w_pa, 2048, WpT, 2048, 0, scr, r, lane); continue; } r -= I_PA;
            if (r < I_PP) { p0_transpose_item(a.w_pp, 2048, WpT, 2048, 1024, scr, r, lane); continue; } r -= I_PP;
            if (r < I_O) { p0_transpose_item(a.w_out, 2048, WoT, 2048, 0, scr, r, lane); continue; } r -= I_O;
            const int gq = r / I_PL; p0_transpose_item(a.w_pool + (size_t)gq * 65536, 256, WplT + (size_t)gq * 65536, 256, 0, scr, r % I_PL, lane);
        }
        for (int it = gt; it < NTOK * DM / 8; it += NT) { const f32x4 v0 = *(const f32x4*)(a.x + (size_t)it * 8), v1 = *(const f32x4*)(a.x + (size_t)it * 8 + 4); *(u32x4*)(XB + (size_t)it * 8) = pack8(v0, v1); }
    }
    grid.sync();
    XcdBarrier xbar = xcd_barrier_post(barw, MISC + 8);
    for (int rep_ = 0; rep_ < NREP(1); ++rep_) if (PHMASK & 2) {
        pg8::Gemm g{XB, WinT, NTOK, HW, DM, DM, DM, 0, 0}; pg8::StaticOrder S; S.init(NTOK, HW, G, bx);
        pg8::EpiH E{H, a.b_gate};
        pg8::gemm_phase<pg8::EpiH, pg8::StaticOrder, true, true>(lds, g, S, E);
    }
    GSYNC();
    for (int rep_ = 0; rep_ < NREP(2); ++rep_) if (PHMASK & 4) { for (int u = bx; u < 2 * 3 * 8 * 32; u += G) attn_unit(lds, H, Og, Lse, u); }
    for (int rep_ = 0; rep_ < NREP(2); ++rep_) if (PHMASK & 4) poolprep(H, Pp, gt, NT);
    GSYNC();
    for (int rep_ = 0; rep_ < NREP(3); ++rep_) if (PHMASK & 8) combine(H, Og, Lse, Y, gt, NT);
    for (int rep_ = 0; rep_ < NREP(3); ++rep_) if (PHMASK & 8) {
        pg8::Gemm g{Pp, WplT, NTOK, 1024, 256, 1024, 256, 512, 0}; pg8::StaticOrder S; S.init(NTOK, 1024, G, bx);
        pg8::EpiPool E{H, a.pool_scale, Y};
        pg8::gemm_phase<pg8::EpiPool, pg8::StaticOrder, true, true>(lds, g, S, E);
    }
    GSYNC();
    for (int rep_ = 0; rep_ < NREP(4); ++rep_) if (PHMASK & 16) {
        pg8::Gemm g{Y, WpT, NTOK, DM, 1024, DM, DM, 0, 2048}; pg8::HalfOrder S; S.init(NTOK, DM, G, bx);
        pg8::EpiMerge E{H, Mg};
        pg8::gemm_phase<pg8::EpiMerge, pg8::HalfOrder, true, true>(lds, g, S, E);
    }
    GSYNC();
    for (int rep_ = 0; rep_ < NREP(5); ++rep_) if (PHMASK & 32) {
        pg8::Gemm g{Mg, WoT, NTOK, DM, DM, DM, DM, 0, 0}; pg8::StaticOrder S; S.init(NTOK, DM, G, bx);
        pg8::EpiOut E{a.x, a.out, ALPHA};
        pg8::gemm_phase<pg8::EpiOut, pg8::StaticOrder, true, true>(lds, g, S, E);
    }
    GSYNC();
    if (PHMASK & 64) for (int row = gw; row < NTOK; row += NGW) {
        float* rp = a.out + (size_t)row * DM + 4 * lane;
        f32x4 v[8]; float s = 0.f;
#pragma unroll
        for (int j = 0; j < 8; ++j) { v[j] = *(const f32x4*)(rp + 256 * j); s += (v[j][0] + v[j][1]) + (v[j][2] + v[j][3]); }
        const float mean = wave_sum(s) * (1.0f / DM); float q = 0.f;
#pragma unroll
        for (int j = 0; j < 8; ++j) { v[j] = v[j] - mean; q += (v[j][0] * v[j][0] + v[j][1] * v[j][1]) + (v[j][2] * v[j][2] + v[j][3] * v[j][3]); }
        const float rstd = 1.0f / sqrtf(wave_sum(q) * (1.0f / DM) + LN_EPS);
#pragma unroll
        for (int j = 0; j < 8; ++j) { const f32x4 gm = *(const f32x4*)(a.gamma + 4 * lane + 256 * j), bt = *(const f32x4*)(a.beta + 4 * lane + 256 * j); *(f32x4*)(rp + 256 * j) = v[j] * rstd * gm + bt; }
    }
}

extern "C" void kernel_launch(void* const* d_in, const int* in_sizes, int n_in, void* d_out, int out_size, void* d_ws, size_t ws_size, hipStream_t stream) {
    static int grid = 0;
    if (grid == 0) {
        if (n_in != 10 || in_sizes[0] != NTOK * DM || out_size != NTOK * DM || ws_size < WS_END) { fprintf(stderr, "kernel_launch: unexpected shapes / workspace (n_in %d, in0 %d, out %d, ws %zu)\n", n_in, n_in > 0 ? in_sizes[0] : -1, out_size, ws_size); grid = -1; return; }
        int dev = 0, cus = 0, per_cu = 0;
        if (hipGetDevice(&dev) != hipSuccess || hipDeviceGetAttribute(&cus, hipDeviceAttributeMultiprocessorCount, dev) != hipSuccess) { grid = -1; return; }
        if (hipFuncSetAttribute((const void*)hybrid_fwd, hipFuncAttributeMaxDynamicSharedMemorySize, LDS_BYTES) != hipSuccess) { fprintf(stderr, "kernel_launch: hipFuncSetAttribute failed\n"); grid = -1; return; }
        if (hipOccupancyMaxActiveBlocksPerMultiprocessor(&per_cu, (const void*)hybrid_fwd, NTHREADS, LDS_BYTES) != hipSuccess || per_cu < 1) { fprintf(stderr, "kernel_launch: occupancy query says %d blocks per CU\n", per_cu); (void)hipGetLastError(); grid = -1; return; }
        grid = cus * 1;
        if (grid % 8 != 0) { fprintf(stderr, "kernel_launch: grid %d not a multiple of 8\n", grid); }
    }
    if (grid < 0) return;
    Args a{};
    a.x = (const float*)d_in[0]; a.w_in = (const float*)d_in[1]; a.b_gate = (const float*)d_in[2]; a.w_pool = (const float*)d_in[3]; a.pool_scale = (const float*)d_in[4];
    a.w_pa = (const float*)d_in[5]; a.w_pp = (const float*)d_in[6]; a.w_out = (const float*)d_in[7]; a.gamma = (const float*)d_in[8]; a.beta = (const float*)d_in[9];
    a.out = (float*)d_out; a.ws = (unsigned char*)d_ws;
    void* args[] = {&a};
    hipError_t e = hipLaunchCooperativeKernel((const void*)hybrid_fwd, dim3(grid), dim3(NTHREADS), args, LDS_BYTES, stream);
    if (e != hipSuccess) fprintf(stderr, "kernel_launch: cooperative launch failed: %s (grid %d)\n", hipGetErrorString(e), grid);
}
```
